# Optimizing an MI355X kernel written in HIP

```python
import math
import jax, jax.numpy as jnp
from jax import lax
import numpy as np

D_MODEL = 1024
BATCH = 16
SEQ = 4096
DEPTH = 1

ATTN_WIDTH = D_MODEL // 2
RNN_WIDTH = D_MODEL - ATTN_WIDTH
ATTN_HEADS = 4
ATTN_HALF_DIM = ATTN_WIDTH // (2 * ATTN_HEADS)
ATTN_V_DIM = 2 * ATTN_HALF_DIM
RNN_HEADS = 4
RNN_HEAD_DIM = RNN_WIDTH // RNN_HEADS
D_FF = 2816
N_BUCKETS = 32
MAX_DISTANCE = 128
Q_BLOCK = 128
CHUNK = 64
EPS = 1e-6
IN_COLS = 3 * ATTN_WIDTH + 5 * RNN_WIDTH

kernel_name = "hymba_diffattn_hgrn2_macaron_encoder"


def rmsnorm(x, w):
    xf = x.astype(jnp.float32)
    y = xf * lax.rsqrt(jnp.mean(xf * xf, axis=-1, keepdims=True) + EPS)
    return (y * w.astype(jnp.float32)).astype(x.dtype)


def rel_bucket(rel):
    nb = N_BUCKETS // 2
    max_exact = nb // 2
    side = jnp.where(rel > 0, nb, 0)
    n = jnp.abs(rel)
    nf = jnp.maximum(n, 1).astype(jnp.float32)
    large = max_exact + (jnp.log(nf / max_exact) / math.log(MAX_DISTANCE / max_exact)
                         * (nb - max_exact)).astype(jnp.int32)
    large = jnp.minimum(large, nb - 1)
    return side + jnp.where(n < max_exact, n, large)


def diff_attention(q, k, v, rel_bias, lam):
    B, S = q.shape[0], q.shape[1]
    nblk = S // Q_BLOCK
    qb = jnp.moveaxis(q.reshape(B, nblk, Q_BLOCK, ATTN_HEADS, 2, ATTN_HALF_DIM), 1, 0)
    starts = jnp.arange(nblk, dtype=jnp.int32) * Q_BLOCK
    k_pos = jnp.arange(S, dtype=jnp.int32)
    scale = ATTN_HALF_DIM ** -0.5

    def block(args):
        q_blk, start = args
        q_pos = start + jnp.arange(Q_BLOCK, dtype=jnp.int32)
        bias = jnp.take(rel_bias, rel_bucket(k_pos[None, :] - q_pos[:, None]), axis=0)
        bias = jnp.transpose(bias, (2, 0, 1)).astype(jnp.float32)
        s = jnp.einsum('bqhcd,bkhcd->bhcqk', q_blk, k).astype(jnp.float32) * scale + bias[None, :, None]
        p = jax.nn.softmax(s, axis=-1)
        w = (p[:, :, 0] - lam * p[:, :, 1]).astype(v.dtype)
        return jnp.einsum('bhqk,bkhe->bqhe', w, v)

    o = lax.map(block, (qb, starts))
    return jnp.moveaxis(o, 0, 1).reshape(B, S, ATTN_HEADS, ATTN_V_DIM)


def hgrn2_chunk_scan(q, k, v, g):
    B, S, H, dk = q.shape
    dv = v.shape[-1]
    n = S // CHUNK

    def chunks(t):
        return jnp.moveaxis(t.reshape(B, n, CHUNK, H, t.shape[-1]), 1, 0)

    qc, kc, vc, gc = chunks(q), chunks(k), chunks(v), chunks(g)
    G = jnp.cumsum(gc, axis=2)
    G_last = G[:, :, -1]
    G_mid = G[:, :, CHUNK // 2 - 1:CHUNK // 2]
    q_intra = qc * jnp.exp(G - G_mid)
    k_intra = kc * jnp.exp(G_mid - G)
    lower = jnp.tril(jnp.ones((CHUNK, CHUNK), dtype=bool))
    A = jnp.einsum('nbthk,nbshk->nbhts', q_intra, k_intra)
    A = jnp.where(lower, A, 0.0)
    o_intra = jnp.einsum('nbhts,nbshv->nbthv', A, vc)
    k_dec = kc * jnp.exp(G_last[:, :, None] - G)

    def step(state, xs):
        kd, vv, gl = xs
        new = jnp.exp(gl)[..., None] * state + jnp.einsum('bchk,bchv->bhkv', kd, vv).astype(jnp.float32)
        return new, state

    s0 = jnp.zeros((B, H, dk, dv), jnp.float32)
    _, s_prev = lax.scan(step, s0, (k_dec, vc, G_last))
    o_inter = jnp.einsum('nbthk,nbhkv->nbthv', qc * jnp.exp(G), s_prev)
    o = o_intra + o_inter
    return jnp.moveaxis(o, 0, 1).reshape(B, S, H, dv)


def hgrn2_gates(f_logits, lb):
    sig = jax.nn.sigmoid(f_logits.astype(jnp.float32))
    log_f = jnp.log(lb + (1.0 - lb) * sig)
    one_minus_f = (1.0 - lb) * (1.0 - sig)
    return log_f, one_minus_f


def swiglu_half_step(h, pre, w_in, w_out, post):
    u = rmsnorm(h, pre)
    gate, up = jnp.split(u @ w_in, 2, axis=-1)
    y = (jax.nn.silu(gate) * up) @ w_out
    return h + 0.5 * rmsnorm(y, post)


def setup_inputs(seed: int = 0) -> dict:
    key = jax.random.key(seed)
    ks = jax.random.split(key, 24)
    f32 = jnp.float32

    def w(k, shape, fan_in):
        return jax.random.normal(k, shape, f32) * fan_in ** -0.5

    def gain(k, shape):
        return 1.0 + 0.02 * jax.random.normal(k, shape, f32)

    L = DEPTH
    return {
        "x": jax.random.normal(ks[0], (BATCH, SEQ, D_MODEL), f32),
        "rel_bias": 0.1 * jax.random.normal(ks[1], (N_BUCKETS, ATTN_HEADS), f32),
        "lb_logits": 0.1 * jax.random.normal(ks[2], (2, DEPTH + 1, RNN_WIDTH), f32),
        "ffn1_pre_norm": gain(ks[3], (L, D_MODEL)),
        "ffn1_w_in": w(ks[4], (L, D_MODEL, 2 * D_FF), D_MODEL),
        "ffn1_w_out": w(ks[5], (L, D_FF, D_MODEL), D_FF),
        "ffn1_post_norm": gain(ks[6], (L, D_MODEL)),
        "mix_pre_norm": gain(ks[7], (L, D_MODEL)),
        "w_mix_in": w(ks[8], (L, D_MODEL, IN_COLS), D_MODEL),
        "lambda_q1": 0.1 * jax.random.normal(ks[9], (L, ATTN_HALF_DIM), f32),
        "lambda_k1": 0.1 * jax.random.normal(ks[10], (L, ATTN_HALF_DIM), f32),
        "lambda_q2": 0.1 * jax.random.normal(ks[11], (L, ATTN_HALF_DIM), f32),
        "lambda_k2": 0.1 * jax.random.normal(ks[12], (L, ATTN_HALF_DIM), f32),
        "attn_head_norm": gain(ks[13], (L, ATTN_V_DIM)),
        "rnn_head_norm": gain(ks[14], (L, RNN_HEAD_DIM)),
        "w_mix_out": w(ks[15], (L, ATTN_WIDTH + RNN_WIDTH, D_MODEL), ATTN_WIDTH + RNN_WIDTH),
        "mix_post_norm": gain(ks[16], (L, D_MODEL)),
        "ffn2_pre_norm": gain(ks[17], (L, D_MODEL)),
        "ffn2_w_in": w(ks[18], (L, D_MODEL, 2 * D_FF), D_MODEL),
        "ffn2_w_out": w(ks[19], (L, D_FF, D_MODEL), D_FF),
        "ffn2_post_norm": gain(ks[20], (L, D_MODEL)),
    }


def reference(x, rel_bias, lb_logits, ffn1_pre_norm, ffn1_w_in, ffn1_w_out, ffn1_post_norm,
              mix_pre_norm, w_mix_in, lambda_q1, lambda_k1, lambda_q2, lambda_k2,
              attn_head_norm, rnn_head_norm, w_mix_out, mix_post_norm,
              ffn2_pre_norm, ffn2_w_in, ffn2_w_out, ffn2_post_norm):
    B, S, _ = x.shape
    splits = [ATTN_WIDTH, 2 * ATTN_WIDTH, 3 * ATTN_WIDTH]
    splits += [3 * ATTN_WIDTH + j * RNN_WIDTH for j in range(1, 5)]
    lb_all = jnp.cumsum(jax.nn.softmax(lb_logits.astype(jnp.float32), axis=1), axis=1)
    h = x
    for layer in range(DEPTH):
        h = swiglu_half_step(h, ffn1_pre_norm[layer], ffn1_w_in[layer], ffn1_w_out[layer],
                             ffn1_post_norm[layer])

        u = rmsnorm(h, mix_pre_norm[layer])
        proj = u @ w_mix_in[layer]
        q_a, k_a, v_a, q_r, i_r, f_fw, f_bw, g_r = jnp.split(proj, splits, axis=-1)

        lambda_init = 0.8 - 0.6 * math.exp(-0.3 * layer)
        lam = (jnp.exp(jnp.sum(lambda_q1[layer] * lambda_k1[layer]).astype(jnp.float32))
               - jnp.exp(jnp.sum(lambda_q2[layer] * lambda_k2[layer]).astype(jnp.float32))
               + lambda_init)
        qa = q_a.reshape(B, S, ATTN_HEADS, 2, ATTN_HALF_DIM)
        ka = k_a.reshape(B, S, ATTN_HEADS, 2, ATTN_HALF_DIM)
        va = v_a.reshape(B, S, ATTN_HEADS, ATTN_V_DIM)
        o_a = diff_attention(qa, ka, va, rel_bias, lam)
        o_a = rmsnorm(o_a, attn_head_norm[layer]) * (1.0 - lambda_init)
        o_a = o_a.reshape(B, S, ATTN_WIDTH)

        lb = lb_all[:, layer]
        g_fw, k_fw = hgrn2_gates(f_fw, lb[0])
        g_bw, k_bw = hgrn2_gates(f_bw, lb[1])
        heads = lambda t: t.reshape(B, S, RNN_HEADS, RNN_HEAD_DIM)
        qr = heads(jax.nn.silu(q_r))
        ir = heads(i_r)
        o_fw = hgrn2_chunk_scan(qr, heads(k_fw), ir, heads(g_fw))
        flip = lambda t: jnp.flip(t, axis=1)
        o_bw = flip(hgrn2_chunk_scan(flip(qr), flip(heads(k_bw)), flip(ir), flip(heads(g_bw))))
        o_r = rmsnorm(o_fw + o_bw, rnn_head_norm[layer]) * jax.nn.silu(heads(g_r))
        o_r = o_r.reshape(B, S, RNN_WIDTH)

        mixed = jnp.concatenate([o_a, o_r.astype(o_a.dtype)], axis=-1) @ w_mix_out[layer]
        h = h + rmsnorm(mixed, mix_post_norm[layer])

        h = swiglu_half_step(h, ffn2_pre_norm[layer], ffn2_w_in[layer], ffn2_w_out[layer],
                             ffn2_post_norm[layer])
    return h.astype(x.dtype)
```

```cpp
#include <hip/hip_runtime.h>
#include <hip/hip_cooperative_groups.h>
#include <cstdio>
#include <cstdint>
namespace cg = cooperative_groups;
namespace pg8 {
#define PG8_LAS __attribute__((address_space(3)))
typedef unsigned short bf16_t;
typedef short bf16x8 __attribute__((ext_vector_type(8)));
typedef float f32x4 __attribute__((ext_vector_type(4)));
typedef unsigned u32x4 __attribute__((ext_vector_type(4)));
constexpr int BM = 256, BK = 64, HALF = 128, HTB = HALF * BK * 2  , STAGE_BYTES = 8 * HTB, NXCD = 8, WGM = 8;

__host__ __device__ __forceinline__ int lds_byte(int r, int c) { const int st = (r >> 4) * 2 + (c >> 5), rr = r & 15, cc = c & 31, ob = rr * 64 + cc * 2; return st * 1024 + (ob ^ (((ob >> 9) & 1) << 5)); }
__host__ __device__ __forceinline__ void stage_rc(int b, int& R, int& C) { const int st = b / 1024, sb = b % 1024, swz = sb ^ (((sb >> 9) & 1) << 5); R = (st >> 1) * 16 + swz / 64; C = (st & 1) * 32 + (swz % 64) / 2; }
__host__ __device__ __forceinline__ int perm32(int rho) { const int n = rho >> 4, i = rho & 15; return 8 * (i >> 2) + 4 * n + (i & 3); }

struct Unit { int pm, pn; };
struct Gemm { const bf16_t* A; const bf16_t* Bt; int M, N, K; };

struct StaticOrder {
    int nM, nN, nwg, G, c;
    __host__ __device__ void init(int M, int N, int G_, int c_) { nM = M / BM; nN = N / BM; nwg = nM * nN; G = G_; c = c_; }
    __host__ __device__ bool next(int i, Unit& u) const {
        const long L = (long)i * G + c; if (L >= nwg) return false;
        int wgid = (int)L; { const int q = nwg / NXCD, r = nwg % NXCD, xcd = wgid % NXCD, off = wgid / NXCD; wgid = (xcd < r ? xcd * (q + 1) : r * (q + 1) + (xcd - r) * q) + off; }
        const int nig = WGM * nN, gid = wgid / nig, fm = gid * WGM, gsz = (nM - fm) < WGM ? (nM - fm) : WGM;
        u.pm = fm + ((wgid % nig) % gsz); u.pn = (wgid % nig) / gsz; return true;
    }
    __device__ __forceinline__ void a_ready(const Unit&) const {}
    __device__ __forceinline__ void done(const Unit&) const {}
};

__device__ __forceinline__ unsigned cvt_pk_bf16(float lo, float hi) { unsigned r; asm volatile("v_cvt_pk_bf16_f32 %0, %1, %2" : "=v"(r) : "v"(lo), "v"(hi)); return r; }
typedef float f32x2 __attribute__((ext_vector_type(2)));
template <class Epi, class Sched, bool ALIGN_EPI = false, bool SP2 = false>
__device__ __forceinline__ void gemm_phase(PG8_LAS unsigned char* lds, const Gemm g, const Sched& S, const Epi& E) {
    const int tid = threadIdx.x, wid = __builtin_amdgcn_readfirstlane(tid >> 6), lane = tid & 63, wr = wid >> 2, wc = wid & 3, fr = lane & 15, fq = lane >> 4;
    const int K = g.K, nt = K / BK;
    unsigned voffA[2], voffB[2];
#pragma unroll
    for (int i = 0; i < 2; ++i) { int R, C; stage_rc(tid * 16 + i * 8192, R, C); const int Rb = Epi::PERM ? ((R & ~31) + perm32(R & 31)) : R;
        voffA[i] = (unsigned)(R * K + C) * 2u; voffB[i] = (unsigned)(Rb * K + C) * 2u; }
    const size_t kstep = (size_t)(BK * 2);
    const size_t hstep = (size_t)HALF * K * 2;
    const size_t tstep = 2 * hstep;
    const unsigned ldsw = (unsigned)wid * 1024u;
    const int aoff = lds_byte(wr * 64 + fr, fq * 8), boff = lds_byte(wc * 32 + fr, fq * 8);
#define PG8_SA(b, h) (((b) * 2 + (h)) * HTB)
#define PG8_SB(b, h) ((4 + (b) * 2 + (h)) * HTB)
#define PG8_STAGE(bufoff, gbase, voff) do { _Pragma("unroll") for (int _i = 0; _i < 2; ++_i) \
        __builtin_amdgcn_global_load_lds((const unsigned*)((const char*)(gbase) + (voff)[_i]), (PG8_LAS unsigned*)(lds + (bufoff) + ldsw + _i * 8192), 16, 0, 0); } while (0)
#define PG8_LDA(dst, b, h) do { _Pragma("unroll") for (int m = 0; m < 4; ++m) _Pragma("unroll") for (int k = 0; k < 2; ++k) dst[m][k] = *(const PG8_LAS bf16x8*)(lds + PG8_SA(b, h) + aoff + m * 2048 + k * 1024); } while (0)
#define PG8_LDB(dst, b, h) do { _Pragma("unroll") for (int n = 0; n < 2; ++n) _Pragma("unroll") for (int k = 0; k < 2; ++k) dst[n][k] = *(const PG8_LAS bf16x8*)(lds + PG8_SB(b, h) + boff + n * 2048 + k * 1024); } while (0)
#define PG8_MMA(ai, bj, At, Bt) do { __builtin_amdgcn_s_setprio(1); _Pragma("unroll") for (int m = 0; m < 4; ++m) _Pragma("unroll") for (int n = 0; n < 2; ++n) _Pragma("unroll") for (int k = 0; k < 2; ++k) \
        acc[ai][bj][m][n] = __builtin_amdgcn_mfma_f32_16x16x32_bf16(Bt[n][k], At[m][k], acc[ai][bj][m][n], 0, 0, 0); __builtin_amdgcn_s_setprio(0); } while (0)
#define PG8_WAIT_V(n) asm volatile("s_waitcnt vmcnt(" #n ")" ::: "memory")
#define PG8_WAIT_L(n) asm volatile("s_waitcnt lgkmcnt(" #n ")" ::: "memory")
#define PG8_BAR __builtin_amdgcn_s_barrier()
#define PG8_SCHED __builtin_amdgcn_sched_barrier(0)
    Unit cur, nxt; int ui = 0;
    if (!S.next(0, cur)) return;
    f32x4 acc[2][2][4][2];
#pragma unroll
    for (int a = 0; a < 2; ++a)
#pragma unroll
        for (int b = 0; b < 2; ++b)
#pragma unroll
            for (int m = 0; m < 4; ++m)
#pragma unroll
                for (int n = 0; n < 2; ++n) acc[a][b][m][n] = (f32x4){0.f, 0.f, 0.f, 0.f};
    bf16x8 At[4][2], B0[2][2], B1[2][2];
    const char* cA = (const char*)g.A + (size_t)cur.pm * tstep; const char* cB = (const char*)g.Bt + (size_t)cur.pn * tstep;
    S.a_ready(cur);
    if constexpr (SP2) {
        PG8_STAGE(PG8_SB(0, 0), cB, voffB); PG8_STAGE(PG8_SB(0, 1), cB + hstep, voffB); PG8_STAGE(PG8_SA(0, 0), cA, voffA); PG8_STAGE(PG8_SA(0, 1), cA + hstep, voffA);
        if (wr == 1) PG8_BAR;
        PG8_WAIT_V(2); PG8_BAR;
        PG8_STAGE(PG8_SB(1, 0), cB + kstep, voffB); PG8_STAGE(PG8_SA(1, 0), cA + kstep, voffA); PG8_STAGE(PG8_SB(1, 1), cB + hstep + kstep, voffB);
        PG8_WAIT_V(6); PG8_BAR;
    } else {
        PG8_STAGE(PG8_SB(0, 0), cB, voffB); PG8_STAGE(PG8_SA(0, 0), cA, voffA); PG8_STAGE(PG8_SB(0, 1), cB + hstep, voffB); PG8_STAGE(PG8_SA(0, 1), cA + hstep, voffA);
        if (wr == 1) PG8_BAR;
        PG8_WAIT_V(4); PG8_BAR;
        PG8_STAGE(PG8_SB(1, 0), cB + kstep, voffB); PG8_STAGE(PG8_SA(1, 0), cA + kstep, voffA); PG8_STAGE(PG8_SB(1, 1), cB + hstep + kstep, voffB);
        PG8_WAIT_V(6); PG8_BAR;
    }
    for (;;) {
        const bool has_next = S.next(ui + 1, nxt);
        const char* nA = has_next ? (const char*)g.A + (size_t)nxt.pm * tstep : cA; const char* nB = has_next ? (const char*)g.Bt + (size_t)nxt.pn * tstep : cB;
        for (int t = 0; t < nt; t += 2) {
            const bool last = (t == nt - 2);
            const char* a1 = cA + (size_t)(t + 1) * kstep;
            const char* a2 = last ? nA : cA + (size_t)(t + 2) * kstep; const char* b2 = last ? nB : cB + (size_t)(t + 2) * kstep;
            const char* a3 = a2 + kstep; const char* b3 = b2 + kstep;
            if (last && has_next) S.a_ready(nxt);
            if constexpr (SP2) {
            PG8_LDB(B0, 0, 0); PG8_LDB(B1, 0, 1); PG8_SCHED; PG8_LDA(At, 0, 0); PG8_STAGE(PG8_SA(1, 1), a1 + hstep, voffA);
            PG8_WAIT_V(8); PG8_WAIT_L(0); PG8_BAR; PG8_MMA(0, 0, At, B0); PG8_MMA(0, 1, At, B1); PG8_BAR; PG8_SCHED;
            PG8_LDA(At, 0, 1); PG8_STAGE(PG8_SB(0, 0), b2, voffB); PG8_STAGE(PG8_SB(0, 1), b2 + hstep, voffB); PG8_STAGE(PG8_SA(0, 0), a2, voffA);
            PG8_WAIT_V(8); PG8_WAIT_L(0); PG8_BAR; PG8_MMA(1, 0, At, B0); PG8_MMA(1, 1, At, B1); PG8_BAR; PG8_SCHED;
            PG8_LDB(B0, 1, 0); PG8_LDB(B1, 1, 1); PG8_SCHED; PG8_LDA(At, 1, 0); PG8_STAGE(PG8_SA(0, 1), a2 + hstep, voffA);
            PG8_WAIT_V(8); PG8_WAIT_L(0); PG8_BAR; PG8_MMA(0, 0, At, B0); PG8_MMA(0, 1, At, B1); PG8_BAR; PG8_SCHED;
            PG8_LDA(At, 1, 1); PG8_STAGE(PG8_SB(1, 0), b3, voffB); PG8_STAGE(PG8_SB(1, 1), b3 + hstep, voffB); PG8_STAGE(PG8_SA(1, 0), a3, voffA);
            PG8_WAIT_V(8); PG8_WAIT_L(0); PG8_BAR; PG8_MMA(1, 0, At, B0); PG8_MMA(1, 1, At, B1); PG8_BAR; PG8_SCHED;
            } else {
            PG8_LDB(B0, 0, 0); PG8_SCHED; PG8_LDA(At, 0, 0); PG8_STAGE(PG8_SA(1, 1), a1 + hstep, voffA);
            PG8_WAIT_L(8); PG8_BAR; PG8_WAIT_L(0); PG8_MMA(0, 0, At, B0); PG8_BAR; PG8_SCHED;
            PG8_LDB(B1, 0, 1); PG8_STAGE(PG8_SB(0, 0), b2, voffB);
            PG8_BAR; PG8_WAIT_L(0); PG8_MMA(0, 1, At, B1); PG8_BAR;
            PG8_LDA(At, 0, 1); PG8_STAGE(PG8_SA(0, 0), a2, voffA);
            PG8_BAR; PG8_WAIT_L(0); PG8_MMA(1, 0, At, B0); PG8_BAR; PG8_SCHED;
            PG8_STAGE(PG8_SB(0, 1), b2 + hstep, voffB);
            PG8_WAIT_V(6); PG8_BAR; PG8_MMA(1, 1, At, B1); PG8_BAR;
            PG8_LDB(B0, 1, 0); PG8_SCHED; PG8_LDA(At, 1, 0); PG8_STAGE(PG8_SA(0, 1), a2 + hstep, voffA);
            PG8_WAIT_L(8); PG8_BAR; PG8_WAIT_L(0); PG8_MMA(0, 0, At, B0); PG8_BAR; PG8_SCHED;
            PG8_LDB(B1, 1, 1); PG8_STAGE(PG8_SB(1, 0), b3, voffB);
            PG8_BAR; PG8_WAIT_L(0); PG8_MMA(0, 1, At, B1); PG8_BAR;
            PG8_LDA(At, 1, 1); PG8_STAGE(PG8_SA(1, 0), a3, voffA);
            PG8_BAR; PG8_WAIT_L(0); PG8_MMA(1, 0, At, B0); PG8_BAR; PG8_SCHED;
            PG8_STAGE(PG8_SB(1, 1), b3 + hstep, voffB);
            PG8_WAIT_V(6); PG8_BAR; PG8_MMA(1, 1, At, B1); PG8_BAR;
            }
        }
        if constexpr (ALIGN_EPI) { if (wr == 0) PG8_BAR; }
        if constexpr (!Epi::AFTER_DRAIN) { E(acc, cur, wr, wc, fr, fq); S.done(cur); }
        if (!has_next) break;
#pragma unroll
        for (int a = 0; a < 2; ++a)
#pragma unroll
            for (int b = 0; b < 2; ++b)
#pragma unroll
                for (int m = 0; m < 4; ++m)
#pragma unroll
                    for (int n = 0; n < 2; ++n) acc[a][b][m][n] = (f32x4){0.f, 0.f, 0.f, 0.f};
        cur = nxt; cA = nA; cB = nB; ++ui;
        if constexpr (ALIGN_EPI) { if (wr == 1) PG8_BAR; }
    }
    PG8_WAIT_V(0);
    if constexpr (!ALIGN_EPI) { if (wr == 0) PG8_BAR; }
    PG8_BAR;
    if constexpr (Epi::AFTER_DRAIN) { E.fused(acc, cur, wr, wc, fr, fq, lds, wid, lane); S.done(cur); }
#undef PG8_SA
#undef PG8_SB
#undef PG8_STAGE
#undef PG8_LDA
#undef PG8_LDB
#undef PG8_MMA
#undef PG8_WAIT_V
#undef PG8_WAIT_L
#undef PG8_BAR
#undef PG8_SCHED
}
}
#define LAS __attribute__((address_space(3)))
typedef unsigned short bf16_t;
typedef short bf16x8 __attribute__((ext_vector_type(8)));
typedef short s16x4 __attribute__((ext_vector_type(4)));
typedef float f32x2 __attribute__((ext_vector_type(2)));
typedef float f32x4 __attribute__((ext_vector_type(4)));
typedef float f32x16 __attribute__((ext_vector_type(16)));
typedef unsigned u32x2 __attribute__((ext_vector_type(2)));
typedef unsigned u32x4 __attribute__((ext_vector_type(4)));

constexpr int NB = 16, SEQ = 4096, DM = 1024, FF = 2816, M = NB * SEQ;
constexpr float EPS = 1e-6f, LOG2E = 1.4426950408889634f;
constexpr float QSCALE = 0.125f * LOG2E;
constexpr size_t MiB = 1u << 20;
constexpr size_t WS_W1IN = 1 * MiB, WS_W1OUT = 12 * MiB, WS_WMIN = 18 * MiB, WS_WMOUT = 26 * MiB, WS_W2IN = 28 * MiB, WS_W2OUT = 39 * MiB;
constexpr size_t WS_LB = 50 * MiB, WS_PART = 45 * MiB, WS_XN = 64 * MiB, WS_Y = 192 * MiB, WS_BIG = 320 * MiB;
constexpr size_t MIXSZ = (size_t)M * 512;
enum { MB_QA = 0, MB_KA, MB_VA, MB_QR, MB_IR, MB_GF, MB_KF, MB_GB, MB_KB, MB_GR };
constexpr int LDS_BYTES = 147456;

__device__ __forceinline__ unsigned pkbf(float lo, float hi) { typedef __bf16 b2 __attribute__((ext_vector_type(2))); f32x2 v = {lo, hi}; b2 b = __builtin_convertvector(v, b2); return __builtin_bit_cast(unsigned, b); }
__device__ __forceinline__ unsigned pkh(float lo, float hi) { typedef _Float16 h2 __attribute__((ext_vector_type(2))); h2 v = {(_Float16)lo, (_Float16)hi}; return __builtin_bit_cast(unsigned, v); }
__device__ __forceinline__ float bflo(unsigned u) { return __uint_as_float(u << 16); }
__device__ __forceinline__ float bfhi(unsigned u) { return __uint_as_float(u & 0xffff0000u); }
__device__ __forceinline__ float hlo(unsigned u) { typedef _Float16 h2 __attribute__((ext_vector_type(2))); h2 v = __builtin_bit_cast(h2, u); return (float)v[0]; }
__device__ __forceinline__ float hhi(unsigned u) { typedef _Float16 h2 __attribute__((ext_vector_type(2))); h2 v = __builtin_bit_cast(h2, u); return (float)v[1]; }
__device__ __forceinline__ float wave_sum(float v) {
#pragma unroll
    for (int o = 1; o < 64; o <<= 1) v += __shfl_xor(v, o);
    return v;
}
__device__ __forceinline__ float sigmoidf_(float z) { return __builtin_amdgcn_rcpf(1.0f + __expf(-z)); }
__device__ __forceinline__ float siluf_(float z) { return z * sigmoidf_(z); }
__device__ __forceinline__ int crow(int i, int h) { return (i & 3) + 8 * (i >> 2) + 4 * h; }
#define MFMA32(a, b, c) __builtin_amdgcn_mfma_f32_32x32x16_bf16((a), (b), (c), 0, 0, 0)
typedef short v4i16_t __attribute__((ext_vector_type(4)));
__device__ __forceinline__ s16x4 trrd(LAS const unsigned char* p) { return __builtin_bit_cast(s16x4, __builtin_amdgcn_ds_read_tr16_b64_v4i16((LAS v4i16_t*)p)); }
__device__ __forceinline__ bf16x8 cat8(s16x4 lo, s16x4 hi) { return (bf16x8){lo[0], lo[1], lo[2], lo[3], hi[0], hi[1], hi[2], hi[3]}; }

using pg8::Unit;
struct EpiSwiglu {
    static constexpr bool PERM = true, AFTER_DRAIN = false;
    bf16_t* H;
    __device__ __forceinline__ void operator()(const f32x4 (&acc)[2][2][4][2], const Unit& u, int wr, int wc, int fr, int fq) const {
        const int row0 = u.pm * 256 + wr * 64 + fr, col0 = u.pn * 128 + wc * 32 + 8 * fq;
#pragma unroll
        for (int ai = 0; ai < 2; ++ai)
#pragma unroll
            for (int m = 0; m < 4; ++m) {
                bf16_t* rowp = H + (size_t)(row0 + ai * 128 + m * 16) * FF + col0;
                float o[8];
#pragma unroll
                for (int n = 0; n < 2; ++n)
#pragma unroll
                    for (int e = 0; e < 4; ++e) o[4 * n + e] = siluf_(acc[ai][0][m][n][e]) * acc[ai][1][m][n][e];
                u32x4 w; w.x = pkbf(o[0], o[1]); w.y = pkbf(o[2], o[3]); w.z = pkbf(o[4], o[5]); w.w = pkbf(o[6], o[7]);
                *(u32x4*)rowp = w;
            }
    }
};
struct EpiY {
    static constexpr bool PERM = true, AFTER_DRAIN = false;
    bf16_t* Y; float* part;
    __device__ __forceinline__ void operator()(const f32x4 (&acc)[2][2][4][2], const Unit& u, int wr, int wc, int fr, int fq) const {
        const int row0 = u.pm * 256 + wr * 64 + fr, col0 = u.pn * 256 + wc * 32 + 8 * fq;
#pragma unroll
        for (int ai = 0; ai < 2; ++ai)
#pragma unroll
            for (int m = 0; m < 4; ++m) {
                const int row = row0 + ai * 128 + m * 16;
                bf16_t* rowp = Y + (size_t)row * DM + col0;
                float ss = 0.f;
#pragma unroll
                for (int bj = 0; bj < 2; ++bj) {
                    const f32x4 v0 = acc[ai][bj][m][0], v1 = acc[ai][bj][m][1];
                    ss += (v0[0] * v0[0] + v0[1] * v0[1]) + (v0[2] * v0[2] + v0[3] * v0[3]) + (v1[0] * v1[0] + v1[1] * v1[1]) + (v1[2] * v1[2] + v1[3] * v1[3]);
                    u32x4 w; w.x = pkbf(v0[0], v0[1]); w.y = pkbf(v0[2], v0[3]); w.z = pkbf(v1[0], v1[1]); w.w = pkbf(v1[2], v1[3]);
                    *(u32x4*)(rowp + bj * 128) = w;
                }
                ss += __shfl_xor(ss, 16); ss += __shfl_xor(ss, 32);
                if (fq == 0) part[(size_t)row * 16 + u.pn * 4 + wc] = ss;
            }
    }
};
struct EpiMix {
    static constexpr bool PERM = true, AFTER_DRAIN = false;
    bf16_t* mix; const float* lbl;
    __device__ __forceinline__ void operator()(const f32x4 (&acc)[2][2][4][2], const Unit& u, int wr, int wc, int fr, int fq) const {
        const int g = u.pn >> 1;
        const int row0 = u.pm * 256 + wr * 64 + fr, col0 = (u.pn & 1) * 256 + wc * 32 + 8 * fq;
        if (g == 5 || g == 6) {
            const int dir = g - 5;
            bf16_t* Gb = mix + (size_t)(MB_GF + 2 * dir) * MIXSZ; bf16_t* Kb = mix + (size_t)(MB_KF + 2 * dir) * MIXSZ;
#pragma unroll
            for (int ai = 0; ai < 2; ++ai)
#pragma unroll
                for (int m = 0; m < 4; ++m) {
                    const size_t ro = (size_t)(row0 + ai * 128 + m * 16) * 512 + col0;
#pragma unroll
                    for (int bj = 0; bj < 2; ++bj) {
                        float gg[8], kk[8];
                        const f32x4 lb0 = *(const f32x4*)(lbl + dir * 512 + col0 + bj * 128), lb1 = *(const f32x4*)(lbl + dir * 512 + col0 + bj * 128 + 4);
#pragma unroll
                        for (int e = 0; e < 8; ++e) {
                            const float z = acc[ai][bj][m][e >> 2][e & 3], lbv = e < 4 ? lb0[e & 3] : lb1[e & 3];
                            const float ez = __expf(-z), sg = __builtin_amdgcn_rcpf(1.0f + ez), om = 1.0f - lbv;
                            gg[e] = __logf(lbv + om * sg); kk[e] = om * (ez * sg);
                        }
                        u32x4 wg, wk;
                        wg.x = pkh(gg[0], gg[1]); wg.y = pkh(gg[2], gg[3]); wg.z = pkh(gg[4], gg[5]); wg.w = pkh(gg[6], gg[7]);
                        wk.x = pkbf(kk[0], kk[1]); wk.y = pkbf(kk[2], kk[3]); wk.z = pkbf(kk[4], kk[5]); wk.w = pkbf(kk[6], kk[7]);
                        *(u32x4*)(Gb + ro + bj * 128) = wg; *(u32x4*)(Kb + ro + bj * 128) = wk;
                    }
                }
        } else {
            bf16_t* O = mix + (size_t)(g < 5 ? g : MB_GR) * MIXSZ;
            const bool dosilu = (g == 3 || g == 7); const float sc = (g == 0) ? QSCALE : 1.0f;
#pragma unroll
            for (int ai = 0; ai < 2; ++ai)
#pragma unroll
                for (int m = 0; m < 4; ++m) {
                    const size_t ro = (size_t)(row0 + ai * 128 + m * 16) * 512 + col0;
#pragma unroll
                    for (int bj = 0; bj < 2; ++bj) {
                        float o[8];
#pragma unroll
                        for (int e = 0; e < 8; ++e) { const float z = acc[ai][bj][m][e >> 2][e & 3]; o[e] = dosilu ? siluf_(z) : z * sc; }
                        u32x4 w; w.x = pkbf(o[0], o[1]); w.y = pkbf(o[2], o[3]); w.z = pkbf(o[4], o[5]); w.w = pkbf(o[6], o[7]);
                        *(u32x4*)(O + ro + bj * 128) = w;
                    }
                }
        }
    }
};

template <int MODE>
__device__ __forceinline__ void transpose_item(const float* W, int K, int N, bf16_t* WT, LAS float* scr, int item, int lane) {
    const int nblk = N / 32, kb = item / nblk, nb = item % nblk, k0 = 64 * kb, n0 = 32 * nb;
#pragma unroll 8
    for (int i = 0; i < 32; ++i) { const int kk = 2 * i + (lane >> 5); scr[kk * 33 + (lane & 31)] = W[(size_t)(k0 + kk) * N + n0 + (lane & 31)]; }
    asm volatile("s_waitcnt lgkmcnt(0)" ::: "memory");
    int d0 = n0;
    if (MODE == 1) { const int half = N / 2; const int up = n0 >= half ? 1 : 0; const int j = n0 - up * half; d0 = (j / 128) * 256 + up * 128 + (j % 128); }
    const int c = lane & 7;
#pragma unroll
    for (int j = 0; j < 4; ++j) { const int n = (lane >> 3) + 8 * j; const LAS float* s = scr + (8 * c) * 33 + n;
        u32x4 o; o.x = pkbf(s[0 * 33], s[1 * 33]); o.y = pkbf(s[2 * 33], s[3 * 33]); o.z = pkbf(s[4 * 33], s[5 * 33]); o.w = pkbf(s[6 * 33], s[7 * 33]);
        *(u32x4*)(WT + (size_t)(d0 + n) * K + k0 + 8 * c) = o; }
    asm volatile("s_waitcnt lgkmcnt(0)" ::: "memory");
}

template <bool HASY, bool WRITEH, bool WRITEXN>
__device__ __forceinline__ void norm_rows(int gw, int ngw, int lane, const float* base, const bf16_t* Y, const float* part, const float* wpost, float alpha,
                                          float* hout, const float* wpre, bf16_t* XN) {
    for (int m = gw; m < M; m += ngw) {
        f32x4 v[4];
#pragma unroll
        for (int j = 0; j < 4; ++j) v[j] = ((const f32x4*)(base + (size_t)m * DM))[lane + 64 * j];
        if (HASY) {
            float ps = part[(size_t)m * 16 + (lane & 15)];
            ps += __shfl_xor(ps, 1); ps += __shfl_xor(ps, 2); ps += __shfl_xor(ps, 4); ps += __shfl_xor(ps, 8);
            const float r = alpha * rsqrtf(ps * (1.0f / DM) + EPS);
#pragma unroll
            for (int j = 0; j < 4; ++j) {
                const u32x2 y = ((const u32x2*)(Y + (size_t)m * DM))[lane + 64 * j];
                const f32x4 w = ((const f32x4*)wpost)[lane + 64 * j];
                v[j][0] += bflo(y.x) * r * w[0]; v[j][1] += bfhi(y.x) * r * w[1]; v[j][2] += bflo(y.y) * r * w[2]; v[j][3] += bfhi(y.y) * r * w[3];
            }
        }
        if (WRITEH) {
#pragma unroll
            for (int j = 0; j < 4; ++j) ((f32x4*)(hout + (size_t)m * DM))[lane + 64 * j] = v[j];
        }
        if (WRITEXN) {
            float s2 = 0.f;
#pragma unroll
            for (int j = 0; j < 4; ++j) s2 += (v[j][0] * v[j][0] + v[j][1] * v[j][1]) + (v[j][2] * v[j][2] + v[j][3] * v[j][3]);
            s2 = wave_sum(s2);
            const float r2 = rsqrtf(s2 * (1.0f / DM) + EPS);
#pragma unroll
            for (int j = 0; j < 4; ++j) {
                const f32x4 w = ((const f32x4*)wpre)[lane + 64 * j];
                u32x2 o; o.x = pkbf(v[j][0] * r2 * w[0], v[j][1] * r2 * w[1]); o.y = pkbf(v[j][2] * r2 * w[2], v[j][3] * r2 * w[3]);
                ((u32x2*)(XN + (size_t)m * DM))[lane + 64 * j] = o;
            }
        }
    }
}
__device__ __forceinline__ void combine_rows(int gw, int ngw, int lane, const bf16_t* OF, const bf16_t* OB, const bf16_t* GR, const float* wr, bf16_t* CAT) {
    for (int m = gw; m < M; m += ngw) {
        const u32x4 a = ((const u32x4*)(OF + (size_t)m * 512))[lane], b = ((const u32x4*)(OB + (size_t)m * 512))[lane], g = ((const u32x4*)(GR + (size_t)m * 512))[lane];
        float v[8];
        v[0] = bflo(a.x) + bflo(b.x); v[1] = bfhi(a.x) + bfhi(b.x); v[2] = bflo(a.y) + bflo(b.y); v[3] = bfhi(a.y) + bfhi(b.y);
        v[4] = bflo(a.z) + bflo(b.z); v[5] = bfhi(a.z) + bfhi(b.z); v[6] = bflo(a.w) + bflo(b.w); v[7] = bfhi(a.w) + bfhi(b.w);
        float ss = 0.f;
#pragma unroll
        for (int e = 0; e < 8; ++e) ss += v[e] * v[e];
        ss += __shfl_xor(ss, 1); ss += __shfl_xor(ss, 2); ss += __shfl_xor(ss, 4); ss += __shfl_xor(ss, 8);
        const float r = rsqrtf(ss * (1.0f / 128.0f) + EPS);
        const f32x4 w0 = ((const f32x4*)wr)[(lane & 15) * 2], w1 = ((const f32x4*)wr)[(lane & 15) * 2 + 1];
        u32x4 o;
        o.x = pkbf(v[0] * r * w0[0] * bflo(g.x), v[1] * r * w0[1] * bfhi(g.x)); o.y = pkbf(v[2] * r * w0[2] * bflo(g.y), v[3] * r * w0[3] * bfhi(g.y));
        o.z = pkbf(v[4] * r * w1[0] * bflo(g.z), v[5] * r * w1[1] * bfhi(g.z)); o.w = pkbf(v[6] * r * w1[2] * bflo(g.w), v[7] * r * w1[3] * bfhi(g.w));
        ((u32x4*)(CAT + (size_t)m * DM + 512))[lane] = o;
    }
}
constexpr int AT_KP = 272, AT_VP = 320, AT_KB = 64 * AT_KP, AT_BUF = AT_KB + 64 * AT_VP, AT_TAB = 2 * AT_BUF;
__device__ __forceinline__ void attn_phase(LAS unsigned char* lds, const bf16_t* QA, const bf16_t* KA, const bf16_t* VA, bf16_t* CAT,
                                           const float* rel_bias, const float* lq1, const float* lk1, const float* lq2, const float* lk2, const float* anorm, int vcu) {
    const int tid = threadIdx.x, lane = tid & 63, wid = __builtin_amdgcn_readfirstlane(tid >> 6), r = lane & 31, h = lane >> 5;
    LAS float* tab = (LAS float*)(lds + AT_TAB);
    const float lam = __expf(wave_sum(lq1[lane] * lk1[lane])) - __expf(wave_sum(lq2[lane] * lk2[lane])) + 0.2f;
    for (int e = tid; e < 4 * 257; e += 512) {
        const int hd = e / 257, idx = e % 257, rel = idx - 128, n = rel < 0 ? -rel : rel, side = rel > 0 ? 16 : 0;
        int bk = n;
        if (n >= 8) { const float lf = logf((float)n / 8.0f) / 2.772588722239781f * 8.0f; bk = 8 + (int)lf; bk = bk < 15 ? bk : 15; }
        tab[hd * 260 + idx] = rel_bias[(side + bk) * 4 + hd] * LOG2E;
    }
    __syncthreads();
    const int c = wid >> 2, qw = wid & 3;
    const int ldrow = tid >> 4, ldch = tid & 15;
    const int trr = 4 * h + ((lane & 15) >> 2), trc = ((lane >> 4) & 1) * 16 + (lane & 3) * 4;
    for (int it = 0; it < 8; ++it) {
        const int unit = it * 256 + vcu, bh = unit >> 5, qb = unit & 31, b = bh >> 2, hd = bh & 3;
        const size_t tok0 = (size_t)b * SEQ;
        const int q0 = qb * 128 + qw * 32;
        bf16x8 qf[4];
        { const bf16_t* qp = QA + (tok0 + q0 + r) * 512 + hd * 128 + c * 64 + 8 * h;
#pragma unroll
          for (int d0 = 0; d0 < 4; ++d0) qf[d0] = *(const bf16x8*)(qp + 16 * d0); }
        f32x16 o[4];
#pragma unroll
        for (int k = 0; k < 4; ++k)
#pragma unroll
            for (int i = 0; i < 16; ++i) o[k][i] = 0.f;
        float mrow = -1e30f, lsum = 0.f;
        const bf16_t* kg = KA + (tok0 + ldrow) * 512 + hd * 128 + ldch * 8;
        const bf16_t* vg = VA + (tok0 + ldrow) * 512 + hd * 128 + ldch * 8;
        u32x4 pk0, pk1, pv0, pv1;
        pk0 = *(const u32x4*)kg; pk1 = *(const u32x4*)(kg + 32 * 512); pv0 = *(const u32x4*)vg; pv1 = *(const u32x4*)(vg + 32 * 512);
        { LAS unsigned char* bb = lds;
          *(LAS u32x4*)(bb + ldrow * AT_KP + ldch * 16) = pk0; *(LAS u32x4*)(bb + (ldrow + 32) * AT_KP + ldch * 16) = pk1;
          *(LAS u32x4*)(bb + AT_KB + ldrow * AT_VP + ldch * 16) = pv0; *(LAS u32x4*)(bb + AT_KB + (ldrow + 32) * AT_VP + ldch * 16) = pv1; }
        __syncthreads();
        const float bleft = tab[hd * 260 + 0], bright = tab[hd * 260 + 256];
        for (int t = 0; t < 64; ++t) {
            LAS unsigned char* cur = lds + (t & 1) * AT_BUF;
            if (t + 1 < 64) { const size_t go = (size_t)(t + 1) * 64 * 512;
                pk0 = *(const u32x4*)(kg + go); pk1 = *(const u32x4*)(kg + go + 32 * 512); pv0 = *(const u32x4*)(vg + go); pv1 = *(const u32x4*)(vg + go + 32 * 512); }
            const int kv0 = t * 64;
            const bool farl = (kv0 + 63 - q0 <= -91), farr = (kv0 - (q0 + 31) >= 91);
            const float cinit = farl ? bleft : (farr ? bright : 0.f);
            f32x16 p0, p1;
#pragma unroll
            for (int i = 0; i < 16; ++i) { p0[i] = cinit; p1[i] = cinit; }
            { LAS const unsigned char* kp = cur + r * AT_KP + (c * 64 + 8 * h) * 2;
#pragma unroll
              for (int d0 = 0; d0 < 4; ++d0) {
                  const bf16x8 ka = *(LAS const bf16x8*)(kp + d0 * 32), kb = *(LAS const bf16x8*)(kp + 32 * AT_KP + d0 * 32);
                  p0 = MFMA32(ka, qf[d0], p0); p1 = MFMA32(kb, qf[d0], p1); } }
            if (!(farl || farr)) {
                const int qpos = q0 + r;
#pragma unroll
                for (int i = 0; i < 16; ++i) {
                    int rel = kv0 + crow(i, h) - qpos; int r2 = rel + 32;
                    rel = rel < -128 ? -128 : (rel > 128 ? 128 : rel); r2 = r2 < -128 ? -128 : (r2 > 128 ? 128 : r2);
                    p0[i] += tab[hd * 260 + rel + 128]; p1[i] += tab[hd * 260 + r2 + 128];
                }
            }
            float mx = p0[0];
#pragma unroll
            for (int i = 1; i < 16; ++i) mx = fmaxf(mx, p0[i]);
#pragma unroll
            for (int i = 0; i < 16; ++i) mx = fmaxf(mx, p1[i]);
            mx = fmaxf(mx, __shfl_xor(mx, 32));
            const float mnew = fmaxf(mrow, mx), alpha = __builtin_amdgcn_exp2f(mrow - mnew);
            mrow = mnew;
            float ls = 0.f;
#pragma unroll
            for (int i = 0; i < 16; ++i) { p0[i] = __builtin_amdgcn_exp2f(p0[i] - mnew); p1[i] = __builtin_amdgcn_exp2f(p1[i] - mnew); ls += p0[i] + p1[i]; }
            lsum = lsum * alpha + ls;
#pragma unroll
            for (int k = 0; k < 4; ++k)
#pragma unroll
                for (int i = 0; i < 16; ++i) o[k][i] *= alpha;
            bf16x8 pf[4];
            { u32x4 w;
              w.x = pkbf(p0[0], p0[1]); w.y = pkbf(p0[2], p0[3]); w.z = pkbf(p0[4], p0[5]); w.w = pkbf(p0[6], p0[7]); pf[0] = __builtin_bit_cast(bf16x8, w);
              w.x = pkbf(p0[8], p0[9]); w.y = pkbf(p0[10], p0[11]); w.z = pkbf(p0[12], p0[13]); w.w = pkbf(p0[14], p0[15]); pf[1] = __builtin_bit_cast(bf16x8, w);
              w.x = pkbf(p1[0], p1[1]); w.y = pkbf(p1[2], p1[3]); w.z = pkbf(p1[4], p1[5]); w.w = pkbf(p1[6], p1[7]); pf[2] = __builtin_bit_cast(bf16x8, w);
              w.x = pkbf(p1[8], p1[9]); w.y = pkbf(p1[10], p1[11]); w.z = pkbf(p1[12], p1[13]); w.w = pkbf(p1[14], p1[15]); pf[3] = __builtin_bit_cast(bf16x8, w); }
            { LAS const unsigned char* vb = cur + AT_KB + trr * AT_VP + trc * 2;
#pragma unroll
              for (int s = 0; s < 4; ++s)
#pragma unroll
                  for (int k = 0; k < 4; ++k) {
                      const s16x4 lo = trrd(vb + (16 * s) * AT_VP + k * 64), hi = trrd(vb + (16 * s + 8) * AT_VP + k * 64);
                      o[k] = MFMA32(cat8(lo, hi), pf[s], o[k]);
                      if (k == 3) __builtin_amdgcn_sched_barrier(0);
                  } }
            if (t + 1 < 64) { LAS unsigned char* bb = lds + ((t + 1) & 1) * AT_BUF;
                *(LAS u32x4*)(bb + ldrow * AT_KP + ldch * 16) = pk0; *(LAS u32x4*)(bb + (ldrow + 32) * AT_KP + ldch * 16) = pk1;
                *(LAS u32x4*)(bb + AT_KB + ldrow * AT_VP + ldch * 16) = pv0; *(LAS u32x4*)(bb + AT_KB + (ldrow + 32) * AT_VP + ldch * 16) = pv1; }
            __syncthreads();
        }
        lsum += __shfl_xor(lsum, 32);
        const float inv = __builtin_amdgcn_rcpf(lsum);
        LAS float* X = (LAS float*)lds;
        if (c == 1) { const float f = lam * inv;
#pragma unroll
            for (int k = 0; k < 4; ++k)
#pragma unroll
                for (int i = 0; i < 16; ++i) X[((qw * 4 + k) * 16 + i) * 64 + lane] = o[k][i] * f; }
        __syncthreads();
        if (c == 0) {
            float ss = 0.f;
#pragma unroll
            for (int k = 0; k < 4; ++k)
#pragma unroll
                for (int i = 0; i < 16; ++i) { const float v = o[k][i] * inv - X[((qw * 4 + k) * 16 + i) * 64 + lane]; o[k][i] = v; ss += v * v; }
            ss += __shfl_xor(ss, 32);
            const float rr = rsqrtf(ss * (1.0f / 128.0f) + EPS) * 0.8f;
            bf16_t* op = CAT + (tok0 + q0 + r) * DM + hd * 128;
#pragma unroll
            for (int k = 0; k < 4; ++k)
#pragma unroll
                for (int i4 = 0; i4 < 4; ++i4) { const int d = 32 * k + 8 * i4 + 4 * h; const f32x4 w = *(const f32x4*)(anorm + d);
                    u32x2 ov; ov.x = pkbf(o[k][4 * i4] * rr * w[0], o[k][4 * i4 + 1] * rr * w[1]); ov.y = pkbf(o[k][4 * i4 + 2] * rr * w[2], o[k][4 * i4 + 3] * rr * w[3]);
                    *(u32x2*)(op + d) = ov; }
        }
        __syncthreads();
    }
}

constexpr int HG_P = 272, HG_KDP = 320, HG_VP = 192, HG_ASP = 144;
constexpr int HG_QI = 0, HG_KI = 64 * HG_P, HG_QG = 2 * 64 * HG_P, HG_KD = 3 * 64 * HG_P, HG_V = HG_KD + 64 * HG_KDP, HG_AS = HG_V + 64 * HG_VP, HG_ST = HG_AS + 64 * HG_ASP,
              HG_EGL = HG_ST + 64 * HG_P, HG_SEG = HG_EGL + 512, HG_END = HG_SEG + 8 * 128 * 4;
static_assert(HG_END <= 131072, "hgrn lds");
__device__ __forceinline__ void hgrn_phase(LAS unsigned char* lds, const bf16_t* mix, bf16_t* OFB, int item) {
    const int tid = threadIdx.x, lane = tid & 63, wid = __builtin_amdgcn_readfirstlane(tid >> 6), r = lane & 31, h = lane >> 5;
    const int dvh = item & 1, dir = (item >> 1) & 1, hh = (item >> 2) & 3, b = item >> 4;
    const bf16_t* QR = mix + (size_t)MB_QR * MIXSZ; const bf16_t* IR = mix + (size_t)MB_IR * MIXSZ;
    const bf16_t* GG = mix + (size_t)(MB_GF + 2 * dir) * MIXSZ; const bf16_t* KK = mix + (size_t)(MB_KF + 2 * dir) * MIXSZ;
    bf16_t* O = OFB + (size_t)dir * MIXSZ;
    const size_t tok0 = (size_t)b * SEQ;
    for (int e = tid; e < 64 * HG_P / 4; e += 512) ((LAS unsigned*)(lds + HG_ST))[e] = 0u;
    f32x16 sacc;
#pragma unroll
    for (int i = 0; i < 16; ++i) sacc[i] = 0.f;
    const int tv = tid >> 3, cv = tid & 7;
    const int trr = 8 * h + ((lane & 15) >> 2), trc = ((lane >> 4) & 1) * 16 + (lane & 3) * 4;
    unsigned cq[8], cg_[8], ck[8]; u32x4 cvv;
#define HG_TOK(c_, t_) (dir ? (SEQ - 1 - ((c_) * 64 + (t_))) : ((c_) * 64 + (t_)))
#define HG_LOAD(c_, q_, g_, k_, v_) do { _Pragma("unroll") for (int j = 0; j < 8; ++j) { const size_t off = (tok0 + HG_TOK(c_, 8 * wid + j)) * 512 + hh * 128 + 2 * lane; \
        q_[j] = *(const unsigned*)(QR + off); g_[j] = *(const unsigned*)(GG + off); k_[j] = *(const unsigned*)(KK + off); } \
        v_ = *(const u32x4*)(IR + (tok0 + HG_TOK(c_, tv)) * 512 + hh * 128 + dvh * 64 + cv * 8); } while (0)
    HG_LOAD(0, cq, cg_, ck, cvv);
    __syncthreads();
    for (int c = 0; c < 64; ++c) {
        float c0[8], c1[8];
        { float a0 = 0.f, a1 = 0.f;
#pragma unroll
          for (int j = 0; j < 8; ++j) { a0 += hlo(cg_[j]); a1 += hhi(cg_[j]); c0[j] = a0; c1[j] = a1; } }
        *(LAS f32x2*)(lds + HG_SEG + (wid * 128 + 2 * lane) * 4) = (f32x2){c0[7], c1[7]};
        unsigned nq[8], ng[8], nk[8]; u32x4 nv;
        if (c + 1 < 64) HG_LOAD(c + 1, nq, ng, nk, nv);
        __syncthreads();
        float pre0 = 0.f, pre1 = 0.f, mid0 = 0.f, mid1 = 0.f, last0 = 0.f, last1 = 0.f;
#pragma unroll
        for (int s = 0; s < 8; ++s) { const f32x2 tt = *(LAS const f32x2*)(lds + HG_SEG + (s * 128 + 2 * lane) * 4);
            if (s < wid) { pre0 += tt[0]; pre1 += tt[1]; } if (s < 4) { mid0 += tt[0]; mid1 += tt[1]; } last0 += tt[0]; last1 += tt[1]; }
        const float eM0 = __expf(mid0), eM1 = __expf(mid1), eL0 = __expf(last0 - mid0), eL1 = __expf(last1 - mid1);
#pragma unroll
        for (int j = 0; j < 8; ++j) {
            const float e10 = __expf(pre0 + c0[j] - mid0), e11 = __expf(pre1 + c1[j] - mid1);
            const float e20 = __builtin_amdgcn_rcpf(e10), e21 = __builtin_amdgcn_rcpf(e11);
            const float qi0 = bflo(cq[j]) * e10, qi1 = bfhi(cq[j]) * e11, ki0 = bflo(ck[j]) * e20, ki1 = bfhi(ck[j]) * e21;
            const int ro = (8 * wid + j), co = 4 * lane;
            *(LAS unsigned*)(lds + HG_QI + ro * HG_P + co) = pkbf(qi0, qi1);
            *(LAS unsigned*)(lds + HG_KI + ro * HG_P + co) = pkbf(ki0, ki1);
            *(LAS unsigned*)(lds + HG_QG + ro * HG_P + co) = pkbf(qi0 * eM0, qi1 * eM1);
            *(LAS unsigned*)(lds + HG_KD + ro * HG_KDP + co) = pkbf(ki0 * eL0, ki1 * eL1);
        }
        *(LAS u32x4*)(lds + HG_V + tv * HG_VP + cv * 16) = cvv;
        if (wid == 0) *(LAS f32x2*)(lds + HG_EGL + 8 * lane) = (f32x2){__expf(last0), __expf(last1)};
        __syncthreads();
        f32x16 oacc;
#pragma unroll
        for (int i = 0; i < 16; ++i) oacc[i] = 0.f;
        const int tb = (wid & 3) >> 1, xb = wid & 1;
        if (wid < 4) {
            if (xb <= tb) {
                f32x16 a;
#pragma unroll
                for (int i = 0; i < 16; ++i) a[i] = 0.f;
#pragma unroll
                for (int ks = 0; ks < 8; ++ks) {
                    const bf16x8 A = *(LAS const bf16x8*)(lds + HG_QI + (32 * tb + r) * HG_P + (16 * ks + 8 * h) * 2);
                    const bf16x8 B = *(LAS const bf16x8*)(lds + HG_KI + (32 * xb + r) * HG_P + (16 * ks + 8 * h) * 2);
                    a = MFMA32(A, B, a);
                }
#pragma unroll
                for (int i = 0; i < 16; ++i) { const int t = 32 * tb + crow(i, h), s = 32 * xb + r; const float v = (s <= t) ? a[i] : 0.f;
                    *(LAS bf16_t*)(lds + HG_AS + t * HG_ASP + s * 2) = (bf16_t)(pkbf(v, v) & 0xffffu); }
            }
        } else {
#pragma unroll
            for (int ks = 0; ks < 8; ++ks) {
                const bf16x8 A = *(LAS const bf16x8*)(lds + HG_QG + (32 * tb + r) * HG_P + (16 * ks + 8 * h) * 2);
                const bf16x8 B = *(LAS const bf16x8*)(lds + HG_ST + (32 * xb + r) * HG_P + (16 * ks + 8 * h) * 2);
                oacc = MFMA32(A, B, oacc);
            }
        }
        __syncthreads();
        if (wid >= 4) {
            const int nks = 2 * (tb + 1);
            for (int ks = 0; ks < nks; ++ks) {
                const bf16x8 A = *(LAS const bf16x8*)(lds + HG_AS + (32 * tb + r) * HG_ASP + (16 * ks + 8 * h) * 2);
                LAS const unsigned char* vp = lds + HG_V + (16 * ks + trr) * HG_VP + (32 * xb + trc) * 2;
                const s16x4 lo = trrd(vp), hi = trrd(vp + 4 * HG_VP);
                oacc = MFMA32(A, cat8(lo, hi), oacc);
            }
#pragma unroll
            for (int i = 0; i < 16; ++i) { const int t = 32 * tb + crow(i, h);
                O[(tok0 + HG_TOK(c, t)) * 512 + hh * 128 + dvh * 64 + 32 * xb + r] = (bf16_t)(pkbf(oacc[i], oacc[i]) & 0xffffu); }
        }
        { const int kb = wid >> 1, vb = wid & 1;
#pragma unroll
          for (int i4 = 0; i4 < 4; ++i4) { const f32x4 eg = *(LAS const f32x4*)(lds + HG_EGL + (32 * kb + 8 * i4 + 4 * h) * 4);
              sacc[4 * i4] *= eg[0]; sacc[4 * i4 + 1] *= eg[1]; sacc[4 * i4 + 2] *= eg[2]; sacc[4 * i4 + 3] *= eg[3]; }
#pragma unroll
          for (int ks = 0; ks < 4; ++ks) {
              LAS const unsigned char* ap = lds + HG_KD + (16 * ks + trr) * HG_KDP + (32 * kb + trc) * 2;
              LAS const unsigned char* bp = lds + HG_V + (16 * ks + trr) * HG_VP + (32 * vb + trc) * 2;
              const s16x4 alo = trrd(ap), ahi = trrd(ap + 4 * HG_KDP), blo = trrd(bp), bhi_ = trrd(bp + 4 * HG_VP);
              sacc = MFMA32(cat8(alo, ahi), cat8(blo, bhi_), sacc);
          }
#pragma unroll
          for (int i4 = 0; i4 < 4; ++i4) { u32x2 w; w.x = pkbf(sacc[4 * i4], sacc[4 * i4 + 1]); w.y = pkbf(sacc[4 * i4 + 2], sacc[4 * i4 + 3]);
              *(LAS u32x2*)(lds + HG_ST + (32 * vb + r) * HG_P + (32 * kb + 8 * i4 + 4 * h) * 2) = w; } }
        if (c + 1 < 64) {
#pragma unroll
            for (int j = 0; j < 8; ++j) { cq[j] = nq[j]; cg_[j] = ng[j]; ck[j] = nk[j]; }
            cvv = nv;
        }
    }
    __syncthreads();
#undef HG_TOK
#undef HG_LOAD
}

struct Params { const float* in[21]; float* out; unsigned char* ws; };
template <int LO, int HI>
__global__ void __launch_bounds__(512, 2) mega(Params p) {
    extern __shared__ __attribute__((aligned(16))) unsigned char lds_raw[];
    LAS unsigned char* lds = (LAS unsigned char*)lds_raw;
    const int tid = threadIdx.x, lane = tid & 63, wid = __builtin_amdgcn_readfirstlane(tid >> 6);
    const int G = gridDim.x, bx = blockIdx.x;
    const int vcu = (G % 8 == 0) ? (bx % 8) * (G / 8) + bx / 8 : bx;
    const int gw = vcu * 8 + wid, ngw = G * 8;
    unsigned char* ws = p.ws;
    bf16_t* W1in = (bf16_t*)(ws + WS_W1IN); bf16_t* W1out = (bf16_t*)(ws + WS_W1OUT); bf16_t* Wmin = (bf16_t*)(ws + WS_WMIN); bf16_t* Wmout = (bf16_t*)(ws + WS_WMOUT);
    bf16_t* W2in = (bf16_t*)(ws + WS_W2IN); bf16_t* W2out = (bf16_t*)(ws + WS_W2OUT);
    float* part = (float*)(ws + WS_PART); bf16_t* XN = (bf16_t*)(ws + WS_XN); bf16_t* Y = (bf16_t*)(ws + WS_Y); bf16_t* BIG = (bf16_t*)(ws + WS_BIG);
    const float* x = p.in[0]; float* out = p.out;

#define IN(k) (LO <= (k) && (k) < HI)
#define GSYNC(k) do { if constexpr (IN(k) && IN((k) + 1)) cg::this_grid().sync(); } while (0)
    if constexpr (IN(0)) {
        LAS float* scr = (LAS float*)(lds + wid * 16384);
        constexpr int I_IN = (DM / 64) * (2 * FF / 32), I_OUT = (FF / 64) * (DM / 32), I_MI = (DM / 64) * (4096 / 32), I_MO = (DM / 64) * (DM / 32);
        constexpr int NIT = 2 * I_IN + 2 * I_OUT + I_MI + I_MO;
        for (int it = gw; it < NIT; it += ngw) {
            int q = it;
            if (q < I_IN) { transpose_item<1>(p.in[4], DM, 2 * FF, W1in, scr, q, lane); continue; } q -= I_IN;
            if (q < I_IN) { transpose_item<1>(p.in[18], DM, 2 * FF, W2in, scr, q, lane); continue; } q -= I_IN;
            if (q < I_OUT) { transpose_item<0>(p.in[5], FF, DM, W1out, scr, q, lane); continue; } q -= I_OUT;
            if (q < I_OUT) { transpose_item<0>(p.in[19], FF, DM, W2out, scr, q, lane); continue; } q -= I_OUT;
            if (q < I_MI) { transpose_item<0>(p.in[8], DM, 4096, Wmin, scr, q, lane); continue; } q -= I_MI;
            transpose_item<0>(p.in[15], DM, DM, Wmout, scr, q, lane);
        }
        if (bx == 0) for (int e = tid; e < 1024; e += 512) { const int d = e >> 9, cc = e & 511; const float l0 = p.in[2][d * 1024 + cc], l1 = p.in[2][d * 1024 + 512 + cc];
            ((float*)(ws + WS_LB))[e] = 1.0f / (1.0f + __expf(l1 - l0)); }
        norm_rows<false, false, true>(gw, ngw, lane, x, nullptr, nullptr, nullptr, 0.f, nullptr, p.in[3], XN);
    }
    GSYNC(0);
    if constexpr (IN(1)) {
    { pg8::Gemm g{XN, W1in, M, 2 * FF, DM}; pg8::StaticOrder S; S.init(M, 2 * FF, G, bx); EpiSwiglu E{BIG};
      pg8::gemm_phase<EpiSwiglu, pg8::StaticOrder, true, true>(lds, g, S, E); }
    }
    GSYNC(1);
    if constexpr (IN(2)) {
    { pg8::Gemm g{BIG, W1out, M, DM, FF}; pg8::StaticOrder S; S.init(M, DM, G, bx); EpiY E{Y, part};
      pg8::gemm_phase<EpiY, pg8::StaticOrder, true, true>(lds, g, S, E); }
    }
    GSYNC(2);
    if constexpr (IN(3)) {
    norm_rows<true, true, true>(gw, ngw, lane, x, Y, part, p.in[6], 0.5f, out, p.in[7], XN);
    }
    GSYNC(3);
    if constexpr (IN(4)) {
    { pg8::Gemm g{XN, Wmin, M, 4096, DM}; pg8::StaticOrder S; S.init(M, 4096, G, bx); EpiMix E{BIG, (const float*)(ws + WS_LB)};
      pg8::gemm_phase<EpiMix, pg8::StaticOrder, true, true>(lds, g, S, E); }
    }
    GSYNC(4);
    if constexpr (IN(5)) {
    for (int item = vcu; item < 256; item += G) hgrn_phase(lds, BIG, Y, item);
    attn_phase(lds, BIG + (size_t)MB_QA * MIXSZ, BIG + (size_t)MB_KA * MIXSZ, BIG + (size_t)MB_VA * MIXSZ, XN, p.in[1], p.in[9], p.in[10], p.in[11], p.in[12], p.in[13], vcu);
    }
    GSYNC(5);
    if constexpr (IN(6)) {
    combine_rows(gw, ngw, lane, Y, Y + MIXSZ, BIG + (size_t)MB_GR * MIXSZ, p.in[14], XN);
    }
    GSYNC(6);
    if constexpr (IN(7)) {
    { pg8::Gemm g{XN, Wmout, M, DM, DM}; pg8::StaticOrder S; S.init(M, DM, G, bx); EpiY E{Y, part};
      pg8::gemm_phase<EpiY, pg8::StaticOrder, true, true>(lds, g, S, E); }
    }
    GSYNC(7);
    if constexpr (IN(8)) {
    norm_rows<true, true, true>(gw, ngw, lane, out, Y, part, p.in[16], 1.0f, out, p.in[17], XN);
    }
    GSYNC(8);
    if constexpr (IN(9)) {
    { pg8::Gemm g{XN, W2in, M, 2 * FF, DM}; pg8::StaticOrder S; S.init(M, 2 * FF, G, bx); EpiSwiglu E{BIG};
      pg8::gemm_phase<EpiSwiglu, pg8::StaticOrder, true, true>(lds, g, S, E); }
    }
    GSYNC(9);
    if constexpr (IN(10)) {
    { pg8::Gemm g{BIG, W2out, M, DM, FF}; pg8::StaticOrder S; S.init(M, DM, G, bx); EpiY E{Y, part};
      pg8::gemm_phase<EpiY, pg8::StaticOrder, true, true>(lds, g, S, E); }
    }
    GSYNC(10);
    if constexpr (IN(11)) {
    norm_rows<true, true, false>(gw, ngw, lane, out, Y, part, p.in[20], 0.5f, out, nullptr, nullptr);
    }
#undef IN
#undef GSYNC
}

#ifndef MK_SPLIT
#define MK_SPLIT 1
#endif
template <int K> static void launch_one(Params& p, int grid, hipStream_t stream) {
    (void)hipFuncSetAttribute((const void*)mega<K, K + 1>, hipFuncAttributeMaxDynamicSharedMemorySize, LDS_BYTES);
    hipLaunchKernelGGL((mega<K, K + 1>), dim3(grid), dim3(512), LDS_BYTES, stream, p);
}
extern "C" void kernel_launch(void* const* d_in, const int* in_sizes, int n_in, void* d_out, int out_size, void* d_ws, size_t ws_size, hipStream_t stream) {
    static int grid = 0;
    if (grid == 0) {
        if (n_in != 21 || out_size != M * DM || ws_size < 960 * MiB) { fprintf(stderr, "kernel_launch: unexpected shapes (n_in %d out %d ws %zu)\n", n_in, out_size, ws_size); grid = -1; return; }
        int dev = 0, cus = 0, per_cu = 0;
        (void)hipGetDevice(&dev); (void)hipDeviceGetAttribute(&cus, hipDeviceAttributeMultiprocessorCount, dev);
#if !MK_SPLIT
        if (hipFuncSetAttribute((const void*)mega<0, 12>, hipFuncAttributeMaxDynamicSharedMemorySize, LDS_BYTES) != hipSuccess) { fprintf(stderr, "kernel_launch: hipFuncSetAttribute failed\n"); grid = -1; return; }
        if (hipOccupancyMaxActiveBlocksPerMultiprocessor(&per_cu, (const void*)mega<0, 12>, 512, LDS_BYTES) != hipSuccess || per_cu < 1) { fprintf(stderr, "kernel_launch: occupancy query says %d\n", per_cu); }
#endif
        (void)per_cu; (void)hipGetLastError();
        grid = cus > 0 ? cus : 256;
    }
    if (grid < 0) return;
    Params p{};
    for (int i = 0; i < 21; ++i) p.in[i] = (const float*)d_in[i];
    p.out = (float*)d_out; p.ws = (unsigned char*)d_ws;
#if MK_SPLIT
    launch_one<0>(p, grid, stream); launch_one<1>(p, grid, stream); launch_one<2>(p, grid, stream); launch_one<3>(p, grid, stream);
    launch_one<4>(p, grid, stream); launch_one<5>(p, grid, stream); launch_one<6>(p, grid, stream); launch_one<7>(p, grid, stream);
    launch_one<8>(p, grid, stream); launch_one<9>(p, grid, stream); launch_one<10>(p, grid, stream); launch_one<11>(p, grid, stream);
#else
    void* args[] = {&p};
    hipError_t e = hipLaunchCooperativeKernel((const void*)mega<0, 12>, dim3(grid), dim3(512), args, LDS_BYTES, stream);
    if (e != hipSuccess) fprintf(stderr, "kernel_launch: cooperative launch failed: %s (grid %d)\n", hipGetErrorString(e), grid);
#endif
}
```

```cpp
#include <hip/hip_runtime.h>
#include <hip/hip_cooperative_groups.h>
#include <cstdio>
#include <cstdint>
namespace cg = cooperative_groups;
namespace pg8 {
#define PG8_LAS __attribute__((address_space(3)))
typedef unsigned short bf16_t;
typedef short bf16x8 __attribute__((ext_vector_type(8)));
typedef float f32x4 __attribute__((ext_vector_type(4)));
typedef unsigned u32x4 __attribute__((ext_vector_type(4)));
constexpr int BM = 256, BK = 64, HALF = 128, HTB = HALF * BK * 2  , STAGE_BYTES = 8 * HTB, NXCD = 8, WGM = 8;

__host__ __device__ __forceinline__ int lds_byte(int r, int c) { const int st = (r >> 4) * 2 + (c >> 5), rr = r & 15, cc = c & 31, ob = rr * 64 + cc * 2; return st * 1024 + (ob ^ (((ob >> 9) & 1) << 5)); }
__host__ __device__ __forceinline__ void stage_rc(int b, int& R, int& C) { const int st = b / 1024, sb = b % 1024, swz = sb ^ (((sb >> 9) & 1) << 5); R = (st >> 1) * 16 + swz / 64; C = (st & 1) * 32 + (swz % 64) / 2; }
__host__ __device__ __forceinline__ int perm32(int rho) { const int n = rho >> 4, i = rho & 15; return 8 * (i >> 2) + 4 * n + (i & 3); }

struct Unit { int pm, pn; };
struct Gemm { const bf16_t* A; const bf16_t* Bt; int M, N, K; };

struct StaticOrder {
    int nM, nN, nwg, G, c;
    __host__ __device__ void init(int M, int N, int G_, int c_) { nM = M / BM; nN = N / BM; nwg = nM * nN; G = G_; c = c_; }
    __host__ __device__ bool next(int i, Unit& u) const {
        const long L = (long)i * G + c; if (L >= nwg) return false;
        int wgid = (int)L; { const int q = nwg / NXCD, r = nwg % NXCD, xcd = wgid % NXCD, off = wgid / NXCD; wgid = (xcd < r ? xcd * (q + 1) : r * (q + 1) + (xcd - r) * q) + off; }
        const int nig = WGM * nN, gid = wgid / nig, fm = gid * WGM, gsz = (nM - fm) < WGM ? (nM - fm) : WGM;
        u.pm = fm + ((wgid % nig) % gsz); u.pn = (wgid % nig) / gsz; return true;
    }
    __device__ __forceinline__ void a_ready(const Unit&) const {}
    __device__ __forceinline__ void done(const Unit&) const {}
};

__device__ __forceinline__ unsigned cvt_pk_bf16(float lo, float hi) { unsigned r; asm volatile("v_cvt_pk_bf16_f32 %0, %1, %2" : "=v"(r) : "v"(lo), "v"(hi)); return r; }
typedef float f32x2 __attribute__((ext_vector_type(2)));
template <class Epi, class Sched, bool ALIGN_EPI = false, bool SP2 = false>
__device__ __forceinline__ void gemm_phase(PG8_LAS unsigned char* lds, const Gemm g, const Sched& S, const Epi& E) {
    int tid = threadIdx.x; asm volatile("" : "+v"(tid));
    const int wid = __builtin_amdgcn_readfirstlane(tid >> 6), lane = tid & 63, wr = wid >> 2, wc = wid & 3, fr = lane & 15, fq = lane >> 4;
    const int K = g.K, nt = K / BK;
    unsigned voffA[2], voffB[2];
#pragma unroll
    for (int i = 0; i < 2; ++i) { int R, C; stage_rc(tid * 16 + i * 8192, R, C); const int Rb = Epi::PERM ? ((R & ~31) + perm32(R & 31)) : R;
        voffA[i] = (unsigned)(R * K + C) * 2u; voffB[i] = (unsigned)(Rb * K + C) * 2u; }
    const size_t kstep = (size_t)(BK * 2);
    const size_t hstep = (size_t)HALF * K * 2;
    const size_t tstep = 2 * hstep;
    const unsigned ldsw = (unsigned)wid * 1024u;
    const int aoff = lds_byte(wr * 64 + fr, fq * 8), boff = lds_byte(wc * 32 + fr, fq * 8);
#define PG8_SA(b, h) (((b) * 2 + (h)) * HTB)
#define PG8_SB(b, h) ((4 + (b) * 2 + (h)) * HTB)
#define PG8_STAGE(bufoff, gbase, voff) do { _Pragma("unroll") for (int _i = 0; _i < 2; ++_i) \
        __builtin_amdgcn_global_load_lds((const unsigned*)((const char*)(gbase) + (voff)[_i]), (PG8_LAS unsigned*)(lds + (bufoff) + ldsw + _i * 8192), 16, 0, 0); } while (0)
#define PG8_LDA(dst, b, h) do { _Pragma("unroll") for (int m = 0; m < 4; ++m) _Pragma("unroll") for (int k = 0; k < 2; ++k) dst[m][k] = *(const PG8_LAS bf16x8*)(lds + PG8_SA(b, h) + aoff + m * 2048 + k * 1024); } while (0)
#define PG8_LDB(dst, b, h) do { _Pragma("unroll") for (int n = 0; n < 2; ++n) _Pragma("unroll") for (int k = 0; k < 2; ++k) dst[n][k] = *(const PG8_LAS bf16x8*)(lds + PG8_SB(b, h) + boff + n * 2048 + k * 1024); } while (0)
#define PG8_MMA(ai, bj, At, Bt) do { __builtin_amdgcn_s_setprio(1); _Pragma("unroll") for (int m = 0; m < 4; ++m) _Pragma("unroll") for (int n = 0; n < 2; ++n) _Pragma("unroll") for (int k = 0; k < 2; ++k) \
        acc[ai][bj][m][n] = __builtin_amdgcn_mfma_f32_16x16x32_bf16(Bt[n][k], At[m][k], acc[ai][bj][m][n], 0, 0, 0); __builtin_amdgcn_s_setprio(0); } while (0)
#define PG8_WAIT_V(n) asm volatile("s_waitcnt vmcnt(" #n ")" ::: "memory")
#define PG8_WAIT_L(n) asm volatile("s_waitcnt lgkmcnt(" #n ")" ::: "memory")
#define PG8_BAR __builtin_amdgcn_s_barrier()
#define PG8_SCHED __builtin_amdgcn_sched_barrier(0)
    Unit cur, nxt; int ui = 0;
    if (!S.next(0, cur)) return;
    f32x4 acc[2][2][4][2];
#pragma unroll
    for (int a = 0; a < 2; ++a)
#pragma unroll
        for (int b = 0; b < 2; ++b)
#pragma unroll
            for (int m = 0; m < 4; ++m)
#pragma unroll
                for (int n = 0; n < 2; ++n) acc[a][b][m][n] = (f32x4){0.f, 0.f, 0.f, 0.f};
    bf16x8 At[4][2], B0[2][2], B1[2][2];
    const char* cA = (const char*)g.A + (size_t)cur.pm * tstep; const char* cB = (const char*)g.Bt + (size_t)cur.pn * tstep;
    S.a_ready(cur);
    if constexpr (SP2) {
        PG8_STAGE(PG8_SB(0, 0), cB, voffB); PG8_STAGE(PG8_SB(0, 1), cB + hstep, voffB); PG8_STAGE(PG8_SA(0, 0), cA, voffA); PG8_STAGE(PG8_SA(0, 1), cA + hstep, voffA);
        if (wr == 1) PG8_BAR;
        PG8_WAIT_V(2); PG8_BAR;
        PG8_STAGE(PG8_SB(1, 0), cB + kstep, voffB); PG8_STAGE(PG8_SA(1, 0), cA + kstep, voffA); PG8_STAGE(PG8_SB(1, 1), cB + hstep + kstep, voffB);
        PG8_WAIT_V(6); PG8_BAR;
    } else {
        PG8_STAGE(PG8_SB(0, 0), cB, voffB); PG8_STAGE(PG8_SA(0, 0), cA, voffA); PG8_STAGE(PG8_SB(0, 1), cB + hstep, voffB); PG8_STAGE(PG8_SA(0, 1), cA + hstep, voffA);
        if (wr == 1) PG8_BAR;
        PG8_WAIT_V(4); PG8_BAR;
        PG8_STAGE(PG8_SB(1, 0), cB + kstep, voffB); PG8_STAGE(PG8_SA(1, 0), cA + kstep, voffA); PG8_STAGE(PG8_SB(1, 1), cB + hstep + kstep, voffB);
        PG8_WAIT_V(6); PG8_BAR;
    }
    for (;;) {
        const bool has_next = S.next(ui + 1, nxt);
        const char* nA = has_next ? (const char*)g.A + (size_t)nxt.pm * tstep : cA; const char* nB = has_next ? (const char*)g.Bt + (size_t)nxt.pn * tstep : cB;
        for (int t = 0; t < nt; t += 2) {
            const bool last = (t == nt - 2);
            const char* a1 = cA + (size_t)(t + 1) * kstep;
            const char* a2 = last ? nA : cA + (size_t)(t + 2) * kstep; const char* b2 = last ? nB : cB + (size_t)(t + 2) * kstep;
            const char* a3 = a2 + kstep; const char* b3 = b2 + kstep;
            if (last && has_next) S.a_ready(nxt);
            if constexpr (SP2) {
            PG8_LDB(B0, 0, 0); PG8_LDB(B1, 0, 1); PG8_SCHED; PG8_LDA(At, 0, 0); PG8_STAGE(PG8_SA(1, 1), a1 + hstep, voffA);
            PG8_WAIT_V(8); PG8_WAIT_L(0); PG8_BAR; PG8_MMA(0, 0, At, B0); PG8_MMA(0, 1, At, B1); PG8_BAR; PG8_SCHED;
            PG8_LDA(At, 0, 1); PG8_STAGE(PG8_SB(0, 0), b2, voffB); PG8_STAGE(PG8_SB(0, 1), b2 + hstep, voffB); PG8_STAGE(PG8_SA(0, 0), a2, voffA);
            PG8_WAIT_V(8); PG8_WAIT_L(0); PG8_BAR; PG8_MMA(1, 0, At, B0); PG8_MMA(1, 1, At, B1); PG8_BAR; PG8_SCHED;
            PG8_LDB(B0, 1, 0); PG8_LDB(B1, 1, 1); PG8_SCHED; PG8_LDA(At, 1, 0); PG8_STAGE(PG8_SA(0, 1), a2 + hstep, voffA);
            PG8_WAIT_V(8); PG8_WAIT_L(0); PG8_BAR; PG8_MMA(0, 0, At, B0); PG8_MMA(0, 1, At, B1); PG8_BAR; PG8_SCHED;
            PG8_LDA(At, 1, 1); PG8_STAGE(PG8_SB(1, 0), b3, voffB); PG8_STAGE(PG8_SB(1, 1), b3 + hstep, voffB); PG8_STAGE(PG8_SA(1, 0), a3, voffA);
            PG8_WAIT_V(8); PG8_WAIT_L(0); PG8_BAR; PG8_MMA(1, 0, At, B0); PG8_MMA(1, 1, At, B1); PG8_BAR; PG8_SCHED;
            } else {
            PG8_LDB(B0, 0, 0); PG8_SCHED; PG8_LDA(At, 0, 0); PG8_STAGE(PG8_SA(1, 1), a1 + hstep, voffA);
            PG8_WAIT_L(8); PG8_BAR; PG8_WAIT_L(0); PG8_MMA(0, 0, At, B0); PG8_BAR; PG8_SCHED;
            PG8_LDB(B1, 0, 1); PG8_STAGE(PG8_SB(0, 0), b2, voffB);
            PG8_BAR; PG8_WAIT_L(0); PG8_MMA(0, 1, At, B1); PG8_BAR;
            PG8_LDA(At, 0, 1); PG8_STAGE(PG8_SA(0, 0), a2, voffA);
            PG8_BAR; PG8_WAIT_L(0); PG8_MMA(1, 0, At, B0); PG8_BAR; PG8_SCHED;
            PG8_STAGE(PG8_SB(0, 1), b2 + hstep, voffB);
            PG8_WAIT_V(6); PG8_BAR; PG8_MMA(1, 1, At, B1); PG8_BAR;
            PG8_LDB(B0, 1, 0); PG8_SCHED; PG8_LDA(At, 1, 0); PG8_STAGE(PG8_SA(0, 1), a2 + hstep, voffA);
            PG8_WAIT_L(8); PG8_BAR; PG8_WAIT_L(0); PG8_MMA(0, 0, At, B0); PG8_BAR; PG8_SCHED;
            PG8_LDB(B1, 1, 1); PG8_STAGE(PG8_SB(1, 0), b3, voffB);
            PG8_BAR; PG8_WAIT_L(0); PG8_MMA(0, 1, At, B1); PG8_BAR;
            PG8_LDA(At, 1, 1); PG8_STAGE(PG8_SA(1, 0), a3, voffA);
            PG8_BAR; PG8_WAIT_L(0); PG8_MMA(1, 0, At, B0); PG8_BAR; PG8_SCHED;
            PG8_STAGE(PG8_SB(1, 1), b3 + hstep, voffB);
            PG8_WAIT_V(6); PG8_BAR; PG8_MMA(1, 1, At, B1); PG8_BAR;
            }
        }
        if constexpr (ALIGN_EPI) { if (wr == 0) PG8_BAR; }
        if constexpr (!Epi::AFTER_DRAIN) { E(acc, cur, wr, wc, fr, fq); S.done(cur); }
        if (!has_next) break;
#pragma unroll
        for (int a = 0; a < 2; ++a)
#pragma unroll
            for (int b = 0; b < 2; ++b)
#pragma unroll
                for (int m = 0; m < 4; ++m)
#pragma unroll
                    for (int n = 0; n < 2; ++n) acc[a][b][m][n] = (f32x4){0.f, 0.f, 0.f, 0.f};
        cur = nxt; cA = nA; cB = nB; ++ui;
        if constexpr (ALIGN_EPI) { if (wr == 1) PG8_BAR; }
    }
    PG8_WAIT_V(0);
    if constexpr (!ALIGN_EPI) { if (wr == 0) PG8_BAR; }
    PG8_BAR;
    if constexpr (Epi::AFTER_DRAIN) { E.fused(acc, cur, wr, wc, fr, fq, lds, wid, lane); S.done(cur); }
#undef PG8_SA
#undef PG8_SB
#undef PG8_STAGE
#undef PG8_LDA
#undef PG8_LDB
#undef PG8_MMA
#undef PG8_WAIT_V
#undef PG8_WAIT_L
#undef PG8_BAR
#undef PG8_SCHED
}
}
#define LAS __attribute__((address_space(3)))
typedef unsigned short bf16_t;
typedef short bf16x8 __attribute__((ext_vector_type(8)));
typedef short s16x4 __attribute__((ext_vector_type(4)));
typedef float f32x2 __attribute__((ext_vector_type(2)));
typedef float f32x4 __attribute__((ext_vector_type(4)));
typedef float f32x16 __attribute__((ext_vector_type(16)));
typedef unsigned u32x2 __attribute__((ext_vector_type(2)));
typedef unsigned u32x4 __attribute__((ext_vector_type(4)));

constexpr int NB = 16, SEQ = 4096, DM = 1024, FF = 2816, M = NB * SEQ;
constexpr float EPS = 1e-6f, LOG2E = 1.4426950408889634f;
constexpr float QSCALE = 0.125f * LOG2E;
constexpr size_t MiB = 1u << 20;
constexpr size_t WS_W1IN = 1 * MiB, WS_W1OUT = 12 * MiB, WS_WMIN = 18 * MiB, WS_WMOUT = 26 * MiB, WS_W2IN = 28 * MiB, WS_W2OUT = 39 * MiB;
constexpr size_t WS_LB = 50 * MiB, WS_XB = 52 * MiB, WS_XN2 = 192 * MiB  , WS_PART = 45 * MiB, WS_XN = 64 * MiB, WS_Y = 192 * MiB, WS_BIG = 320 * MiB;
constexpr size_t MIXSZ = (size_t)M * 512;
enum { MB_QA = 0, MB_KA, MB_VA, MB_QR, MB_IR, MB_GF, MB_KF, MB_GB, MB_KB, MB_GR };
constexpr int LDS_BYTES = 147456;
constexpr int CTL_BAR = 3 * 256 * 64;

__device__ __forceinline__ unsigned pkbf(float lo, float hi) { typedef __bf16 b2 __attribute__((ext_vector_type(2))); f32x2 v = {lo, hi}; b2 b = __builtin_convertvector(v, b2); return __builtin_bit_cast(unsigned, b); }
__device__ __forceinline__ unsigned pkh(float lo, float hi) { typedef _Float16 h2 __attribute__((ext_vector_type(2))); h2 v = {(_Float16)lo, (_Float16)hi}; return __builtin_bit_cast(unsigned, v); }
__device__ __forceinline__ float bflo(unsigned u) { return __uint_as_float(u << 16); }
__device__ __forceinline__ float bfhi(unsigned u) { return __uint_as_float(u & 0xffff0000u); }
__device__ __forceinline__ float hlo(unsigned u) { typedef _Float16 h2 __attribute__((ext_vector_type(2))); h2 v = __builtin_bit_cast(h2, u); return (float)v[0]; }
__device__ __forceinline__ float hhi(unsigned u) { typedef _Float16 h2 __attribute__((ext_vector_type(2))); h2 v = __builtin_bit_cast(h2, u); return (float)v[1]; }
__device__ __forceinline__ float wave_sum(float v) {
#pragma unroll
    for (int o = 1; o < 64; o <<= 1) v += __shfl_xor(v, o);
    return v;
}
__device__ __forceinline__ float sigmoidf_(float z) { return __builtin_amdgcn_rcpf(1.0f + __expf(-z)); }
__device__ __forceinline__ float siluf_(float z) { return z * sigmoidf_(z); }
__device__ __forceinline__ int crow(int i, int h) { return (i & 3) + 8 * (i >> 2) + 4 * h; }
#define MFMA32(a, b, c) __builtin_amdgcn_mfma_f32_32x32x16_bf16((a), (b), (c), 0, 0, 0)
typedef short v4i16_t __attribute__((ext_vector_type(4)));
__device__ __forceinline__ s16x4 trrd(LAS const unsigned char* p) { return __builtin_bit_cast(s16x4, __builtin_amdgcn_ds_read_tr16_b64_v4i16((LAS v4i16_t*)p)); }
__device__ __forceinline__ bf16x8 cat8(s16x4 lo, s16x4 hi) { return (bf16x8){lo[0], lo[1], lo[2], lo[3], hi[0], hi[1], hi[2], hi[3]}; }

using pg8::Unit;
__host__ __device__ __forceinline__ int mix_tile(int t) { return (t == 8 || t == 9) ? t + 6 : ((t == 14 || t == 15) ? t - 6 : t); }
__device__ __forceinline__ float row_scale(const float* part2, int row) {
    const f32x4 a = *(const f32x4*)(part2 + (size_t)row * 16), b = *(const f32x4*)(part2 + (size_t)row * 16 + 4), c = *(const f32x4*)(part2 + (size_t)row * 16 + 8), d = *(const f32x4*)(part2 + (size_t)row * 16 + 12);
    const float s = ((a[0] + a[1]) + (a[2] + a[3])) + ((b[0] + b[1]) + (b[2] + b[3])) + ((c[0] + c[1]) + (c[2] + c[3])) + ((d[0] + d[1]) + (d[2] + d[3]));
    return rsqrtf(s * (1.0f / DM) + EPS);
}
struct EpiSwiglu {
    static constexpr bool PERM = true, AFTER_DRAIN = false;
    bf16_t* H; const LAS float* rsl;
    __device__ __forceinline__ void operator()(const f32x4 (&acc)[2][2][4][2], const Unit& u, int wr, int wc, int fr, int fq) const {
        const int row0 = u.pm * 256 + wr * 64 + fr, col0 = u.pn * 128 + wc * 32 + 8 * fq;
        const LAS float* rsp = rsl + ((u.pm >> 3) & 3) * 256 + wr * 64 + fr;
#pragma unroll
        for (int ai = 0; ai < 2; ++ai)
#pragma unroll
            for (int m = 0; m < 4; ++m) {
                bf16_t* rowp = H + (size_t)(row0 + ai * 128 + m * 16) * FF + col0;
                const float rsc = rsp[ai * 128 + m * 16];
                float o[8];
#pragma unroll
                for (int n = 0; n < 2; ++n)
#pragma unroll
                    for (int e = 0; e < 4; ++e) o[4 * n + e] = siluf_(acc[ai][0][m][n][e] * rsc) * (acc[ai][1][m][n][e] * rsc);
                u32x4 w; w.x = pkbf(o[0], o[1]); w.y = pkbf(o[2], o[3]); w.z = pkbf(o[4], o[5]); w.w = pkbf(o[6], o[7]);
                __builtin_nontemporal_store(w, (u32x4*)rowp);
            }
    }
};
template <bool LAST, bool BASEBF> struct EpiResNorm {
    static constexpr bool PERM = true, AFTER_DRAIN = false;
    const void* base; float* out; const LAS float* wpost; float alpha; bf16_t* XNo; float* part2;
    float* xbuf; unsigned* cnt; LAS unsigned char* xl;
    __device__ __forceinline__ void operator()(const f32x4 (&acc)[2][2][4][2], const Unit& u, int wr, int wc, int fr, int fq) const {
        const int lane = fr + 16 * fq, wid = wr * 4 + wc;
        LAS float* P = (LAS float*)xl; LAS float* S = (LAS float*)(xl + 4096);
        const int col0 = u.pn * 256 + wc * 32 + 8 * fq;
        const size_t rob = (size_t)(u.pm * 256 + wr * 64 + fr) * DM + col0;
        static_assert(BASEBF, "the residual stream is bf16");
        u32x4 rb[4][2];
#define ER_LOAD(st_) do { _Pragma("unroll") for (int bj = 0; bj < 2; ++bj) rb[(st_) & 3][bj] = *(const u32x4*)((const bf16_t*)base + rob + (size_t)(((st_) >> 2) * 128 + ((st_) & 3) * 16) * DM + bj * 128); } while (0)
        ER_LOAD(0); ER_LOAD(1); ER_LOAD(2); ER_LOAD(3);
#pragma unroll
        for (int ai = 0; ai < 2; ++ai)
#pragma unroll
            for (int m = 0; m < 4; ++m) {
                float ss = 0.f;
#pragma unroll
                for (int bj = 0; bj < 2; ++bj)
#pragma unroll
                    for (int n = 0; n < 2; ++n) { const f32x4 v = acc[ai][bj][m][n]; ss += (v[0] * v[0] + v[1] * v[1]) + (v[2] * v[2] + v[3] * v[3]); }
                ss += __shfl_xor(ss, 16); ss += __shfl_xor(ss, 32);
                if (fq == 0) P[(ai * 128 + wr * 64 + m * 16 + fr) * 4 + wc] = ss;
            }
        asm volatile("s_waitcnt lgkmcnt(0)" ::: "memory"); __builtin_amdgcn_s_barrier(); asm volatile("" ::: "memory");
        const int row = wid * 32 + (lane & 31);
        if (lane < 32) { const f32x4 pp = *(LAS const f32x4*)(P + row * 4);
            __hip_atomic_store(xbuf + ((size_t)(u.pm * 4 + u.pn) * 256 + row), (pp[0] + pp[1]) + (pp[2] + pp[3]), __ATOMIC_RELAXED, __HIP_MEMORY_SCOPE_AGENT); }
        asm volatile("s_waitcnt vmcnt(0)" ::: "memory");
        if (lane == 0) __hip_atomic_fetch_add(cnt + 64 * u.pm, 1u, __ATOMIC_RELAXED, __HIP_MEMORY_SCOPE_AGENT);
        if (wid == 0) { unsigned spins = 0;
            while ((unsigned)__builtin_amdgcn_readfirstlane((int)__hip_atomic_load(cnt + 64 * u.pm, __ATOMIC_RELAXED, __HIP_MEMORY_SCOPE_AGENT)) < 32u) { __builtin_amdgcn_s_sleep(2); if (++spins > (1u << 18)) break; }
            __builtin_amdgcn_fence(__ATOMIC_ACQUIRE, "agent"); }
        asm volatile("s_waitcnt vmcnt(0) lgkmcnt(0)" ::: "memory"); __builtin_amdgcn_s_barrier(); asm volatile("" ::: "memory");
        if (lane < 32) { const float* sl = xbuf + (size_t)(u.pm * 4) * 256 + row; float s4 = 0.f;
#pragma unroll
            for (int t = 0; t < 4; ++t) s4 += __hip_atomic_load(sl + t * 256, __ATOMIC_RELAXED, __HIP_MEMORY_SCOPE_AGENT);
            S[row] = alpha * rsqrtf(s4 * (1.0f / DM) + EPS); }
        asm volatile("s_waitcnt vmcnt(0) lgkmcnt(0)" ::: "memory"); __builtin_amdgcn_s_barrier(); asm volatile("" ::: "memory");
#pragma unroll
        for (int st = 0; st < 8; ++st) {
            const int ai = st >> 2, m = st & 3;
            const int rl = ai * 128 + wr * 64 + m * 16 + fr; const size_t ro = rob + (size_t)(ai * 128 + m * 16) * DM;
            f32x4 cb[2][2];
#pragma unroll
            for (int bj = 0; bj < 2; ++bj) { const u32x4 q = rb[st & 3][bj];
                cb[bj][0] = (f32x4){bflo(q.x), bfhi(q.x), bflo(q.y), bfhi(q.y)}; cb[bj][1] = (f32x4){bflo(q.z), bfhi(q.z), bflo(q.w), bfhi(q.w)}; }
            if (st < 4) ER_LOAD(st + 4);
            const float r = S[rl]; float ss = 0.f;
            int cw = col0; asm volatile("" : "+v"(cw));
#pragma unroll
            for (int bj = 0; bj < 2; ++bj) {
                const f32x4 w0 = *(const LAS f32x4*)(wpost + cw + bj * 128), w1 = *(const LAS f32x4*)(wpost + cw + bj * 128 + 4);
                const f32x4 h0 = cb[bj][0] + acc[ai][bj][m][0] * r * w0, h1 = cb[bj][1] + acc[ai][bj][m][1] * r * w1;
                if (LAST) { __builtin_nontemporal_store(h0, (f32x4*)(out + ro + bj * 128)); __builtin_nontemporal_store(h1, (f32x4*)(out + ro + bj * 128 + 4)); }
                else {
                    ss += (h0[0] * h0[0] + h0[1] * h0[1]) + (h0[2] * h0[2] + h0[3] * h0[3]) + (h1[0] * h1[0] + h1[1] * h1[1]) + (h1[2] * h1[2] + h1[3] * h1[3]);
                    u32x4 w; w.x = pkbf(h0[0], h0[1]); w.y = pkbf(h0[2], h0[3]); w.z = pkbf(h1[0], h1[1]); w.w = pkbf(h1[2], h1[3]);
                    *(u32x4*)(XNo + ro + bj * 128) = w;
                }
            }
            if (!LAST) { ss += __shfl_xor(ss, 16); ss += __shfl_xor(ss, 32); if (fq == 0) part2[(size_t)(u.pm * 256 + rl) * 16 + u.pn * 4 + wc] = ss; }
        }
#undef ER_LOAD
    }
};
__device__ __forceinline__ void stage_gain(LAS float* wl, const float* w, int tid) { wl[tid] = w[tid]; wl[tid + 512] = w[tid + 512]; __syncthreads(); }
__device__ __forceinline__ void fill_row_scales(LAS float* rsl, const float* part2, int bx, int tid) {
    for (int e = tid; e < 1024; e += 512) { const int g4 = e >> 8, rw = e & 255, pm = 8 * (4 * (bx & 7) + g4) + ((bx >> 3) & 7); rsl[e] = row_scale(part2, pm * 256 + rw); }
    __syncthreads();
}
struct EpiMix {
    static constexpr bool PERM = true, AFTER_DRAIN = false;
    bf16_t* mix; const LAS float* lbl; const LAS float* rsl;
    __device__ __forceinline__ void operator()(const f32x4 (&acc)[2][2][4][2], const Unit& u, int wr, int wc, int fr, int fq) const {
        const int lp = mix_tile(u.pn), g = lp >> 1;
        const int row0 = u.pm * 256 + wr * 64 + fr, col0 = (lp & 1) * 256 + wc * 32 + 8 * fq;
        const LAS float* rsp = rsl + ((u.pm >> 3) & 3) * 256 + wr * 64 + fr;
        if (g == 5 || g == 6) {
            const int dir = g - 5;
            bf16_t* Kb = mix + (size_t)(MB_KF + 2 * dir) * MIXSZ;
#pragma unroll
            for (int ai = 0; ai < 2; ++ai)
#pragma unroll
                for (int m = 0; m < 4; ++m) {
                    const size_t ro = (size_t)(row0 + ai * 128 + m * 16) * 512 + col0;
                    const float rsc = rsp[ai * 128 + m * 16];
#pragma unroll
                    for (int bj = 0; bj < 2; ++bj) {
                        float kk[8];
                        const f32x4 lb0 = *(const LAS f32x4*)(lbl + dir * 512 + col0 + bj * 128), lb1 = *(const LAS f32x4*)(lbl + dir * 512 + col0 + bj * 128 + 4);
#pragma unroll
                        for (int e = 0; e < 8; ++e) {
                            const float z = acc[ai][bj][m][e >> 2][e & 3] * rsc, lbv = e < 4 ? lb0[e & 3] : lb1[e & 3];
                            const float ez = __expf(-z), sg = __builtin_amdgcn_rcpf(1.0f + ez), om = 1.0f - lbv;
                            kk[e] = om * (ez * sg);
                        }
                        u32x4 wk;
                        wk.x = pkbf(kk[0], kk[1]); wk.y = pkbf(kk[2], kk[3]); wk.z = pkbf(kk[4], kk[5]); wk.w = pkbf(kk[6], kk[7]);
                        __builtin_nontemporal_store(wk, (u32x4*)(Kb + ro + bj * 128));
                    }
                }
        } else {
            bf16_t* O = mix + (size_t)(g < 5 ? g : MB_GR) * MIXSZ;
            const bool dosilu = (g == 3 || g == 7); const float sc = (g == 0) ? QSCALE : 1.0f;
#pragma unroll
            for (int ai = 0; ai < 2; ++ai)
#pragma unroll
                for (int m = 0; m < 4; ++m) {
                    const size_t ro = (size_t)(row0 + ai * 128 + m * 16) * 512 + col0;
                    const float rsc = rsp[ai * 128 + m * 16];
#pragma unroll
                    for (int bj = 0; bj < 2; ++bj) {
                        float o[8];
                        if (dosilu) { _Pragma("unroll") for (int e = 0; e < 8; ++e) o[e] = siluf_(acc[ai][bj][m][e >> 2][e & 3] * rsc); }
                        else { const float rs2 = rsc * sc; _Pragma("unroll") for (int e = 0; e < 8; ++e) o[e] = acc[ai][bj][m][e >> 2][e & 3] * rs2; }
                        u32x4 w; w.x = pkbf(o[0], o[1]); w.y = pkbf(o[2], o[3]); w.z = pkbf(o[4], o[5]); w.w = pkbf(o[6], o[7]);
                        __builtin_nontemporal_store(w, (u32x4*)(O + ro + bj * 128));
                    }
                }
        }
    }
};

template <int MODE>
__device__ __forceinline__ void transpose_item(const float* W, int K, int N, bf16_t* WT, LAS float* scr, int item, int lane, const float* kw) {
    const int nblk = N / 32, kb = item / nblk, nb = item % nblk, k0 = 64 * kb, n0 = 32 * nb;
    { f32x4 t[8];
#pragma unroll
      for (int i = 0; i < 8; ++i) t[i] = __builtin_nontemporal_load((const f32x4*)(W + (size_t)(k0 + 8 * i + (lane >> 3)) * N + n0 + 4 * (lane & 7)));
#pragma unroll
      for (int i = 0; i < 8; ++i) { LAS float* d = scr + (8 * i + (lane >> 3)) * 33 + 4 * (lane & 7); const float g = kw ? kw[k0 + 8 * i + (lane >> 3)] : 1.0f; d[0] = t[i][0] * g; d[1] = t[i][1] * g; d[2] = t[i][2] * g; d[3] = t[i][3] * g; } }
    asm volatile("s_waitcnt lgkmcnt(0)" ::: "memory");
    int d0 = n0;
    if (MODE == 1) { const int half = N / 2; const int up = n0 >= half ? 1 : 0; const int j = n0 - up * half; d0 = (j / 128) * 256 + up * 128 + (j % 128); }
    if (MODE == 2) d0 = mix_tile(n0 >> 8) * 256 + (n0 & 255);
    const int c = lane & 7;
#pragma unroll
    for (int j = 0; j < 4; ++j) { const int n = (lane >> 3) + 8 * j; const LAS float* s = scr + (8 * c) * 33 + n;
        u32x4 o; o.x = pkbf(s[0 * 33], s[1 * 33]); o.y = pkbf(s[2 * 33], s[3 * 33]); o.z = pkbf(s[4 * 33], s[5 * 33]); o.w = pkbf(s[6 * 33], s[7 * 33]);
        *(u32x4*)(WT + (size_t)(d0 + n) * K + k0 + 8 * c) = o; }
    asm volatile("s_waitcnt lgkmcnt(0)" ::: "memory");
}

template <bool HASY, bool WRITEH, bool WRITEXN>
__device__ __forceinline__ void norm_rows(int gw, int ngw, int lane, const float* base, const bf16_t* Y, const float* part, const float* wpost, float alpha,
                                          float* hout, const float* wpre, bf16_t* XN) {
    constexpr int RB = 4;
    for (int m0 = gw * RB; m0 < M; m0 += ngw * RB) {
        f32x4 v[RB][4]; u32x2 y[RB][4]; float ps[RB];
#pragma unroll
        for (int rr = 0; rr < RB; ++rr) {
            const size_t m = (size_t)(m0 + rr);
#pragma unroll
            for (int j = 0; j < 4; ++j) v[rr][j] = __builtin_nontemporal_load(((const f32x4*)(base + m * DM)) + lane + 64 * j);
            if (HASY) {
#pragma unroll
                for (int j = 0; j < 4; ++j) y[rr][j] = __builtin_nontemporal_load(((const u32x2*)(Y + m * DM)) + lane + 64 * j);
                ps[rr] = part[m * 16 + (lane & 15)];
            }
        }
#pragma unroll
        for (int rr = 0; rr < RB; ++rr) {
            const size_t m = (size_t)(m0 + rr);
            if (HASY) {
                float p = ps[rr];
                p += __shfl_xor(p, 1); p += __shfl_xor(p, 2); p += __shfl_xor(p, 4); p += __shfl_xor(p, 8);
                const float r = alpha * rsqrtf(p * (1.0f / DM) + EPS);
#pragma unroll
                for (int j = 0; j < 4; ++j) {
                    const f32x4 w = ((const f32x4*)wpost)[lane + 64 * j];
                    v[rr][j][0] += bflo(y[rr][j].x) * r * w[0]; v[rr][j][1] += bfhi(y[rr][j].x) * r * w[1]; v[rr][j][2] += bflo(y[rr][j].y) * r * w[2]; v[rr][j][3] += bfhi(y[rr][j].y) * r * w[3];
                }
            }
            if (WRITEH) {
#pragma unroll
                for (int j = 0; j < 4; ++j) ((f32x4*)(hout + m * DM))[lane + 64 * j] = v[rr][j];
            }
            if (WRITEXN) {
                float s2 = 0.f;
#pragma unroll
                for (int j = 0; j < 4; ++j) s2 += (v[rr][j][0] * v[rr][j][0] + v[rr][j][1] * v[rr][j][1]) + (v[rr][j][2] * v[rr][j][2] + v[rr][j][3] * v[rr][j][3]);
                s2 = wave_sum(s2);
                if (lane < 16) hout[m * 16 + lane] = (lane == 0) ? s2 : 0.f;
#pragma unroll
                for (int j = 0; j < 4; ++j) {
                    u32x2 o; o.x = pkbf(v[rr][j][0], v[rr][j][1]); o.y = pkbf(v[rr][j][2], v[rr][j][3]);
                    ((u32x2*)(XN + m * DM))[lane + 64 * j] = o;
                }
            }
        }
    }
}
constexpr int AT_QP = 144, AT_KB = 16384, AT_VB = 16384, AT_V0 = 3 * AT_KB, AT_Q = AT_V0 + 2 * AT_VB, AT_TAB = AT_Q + 8 * 32 * AT_QP;
static_assert(AT_TAB + 4 * 324 * 4 <= 131072 && AT_Q >= 65536, "attention lds");
__device__ __forceinline__ void glds16(unsigned voff, const void* gbase, unsigned lds_dst) { unsigned keep;
    asm volatile("s_mov_b32 %0, m0\n\ts_mov_b32 m0, %2\n\ts_nop 0\n\tglobal_load_lds_dwordx4 %1, %3\n\ts_mov_b32 m0, %0" : "=&s"(keep) : "v"(voff), "s"(lds_dst), "s"(gbase) : "memory"); }
#define AT_WAIT_BAR() asm volatile("s_waitcnt vmcnt(0) lgkmcnt(0)\n\ts_barrier" ::: "memory")
__device__ __forceinline__ float xhalf_max(float m) { auto rr = __builtin_amdgcn_permlane32_swap(__float_as_uint(m), __float_as_uint(m), false, false); return fmaxf(__uint_as_float(rr[0]), __uint_as_float(rr[1])); }
__device__ __forceinline__ float xhalf_sum(float m) { auto rr = __builtin_amdgcn_permlane32_swap(__float_as_uint(m), __float_as_uint(m), false, false); return __uint_as_float(rr[0]) + __uint_as_float(rr[1]); }
__device__ __forceinline__ void attn_phase(LAS unsigned char* lds, const bf16_t* QA, const bf16_t* KA, const bf16_t* VA, bf16_t* CAT, const bf16_t* OF, const bf16_t* OB, const bf16_t* GR, const float* rnorm,
                                           const float* rel_bias, const float* lq1, const float* lk1, const float* lq2, const float* lk2, const float* anorm, int vcu) {
    int tid = threadIdx.x; asm volatile("" : "+v"(tid));
    const int lane = tid & 63, wid = __builtin_amdgcn_readfirstlane(tid >> 6), r = lane & 31, h = lane >> 5;
    LAS float* tab = (LAS float*)(lds + AT_TAB);
    const float lam = __expf(wave_sum(lq1[lane] * lk1[lane])) - __expf(wave_sum(lq2[lane] * lk2[lane])) + 0.2f;
    for (int e = tid; e < 4 * 321; e += 512) {
        const int hd = e / 321, idx = e % 321, rel = idx - 160, n = rel < 0 ? -rel : rel, side = rel > 0 ? 16 : 0;
        int bk = n;
        if (n >= 8) { const float lf = logf((float)n / 8.0f) / 2.772588722239781f * 8.0f; bk = 8 + (int)lf; bk = bk < 15 ? bk : 15; }
        tab[hd * 324 + idx] = rel_bias[(side + bk) * 4 + hd] * LOG2E;
    }
    __syncthreads();
    const int c = wid >> 2, qw = wid & 3;
    const unsigned lds0 = (unsigned)(uintptr_t)lds;
    const unsigned dmaoff = (unsigned)wid * 1024u;
    unsigned kvo0, kvo1, vvo0, vvo1;
    { const int drow0 = 4 * wid + (lane >> 4), drow1 = drow0 + 32, dsl = lane & 15;
      kvo0 = (unsigned)(drow0 * 512 + (dsl ^ (drow0 & 15)) * 8) * 2u; kvo1 = (unsigned)(drow1 * 512 + (dsl ^ (drow1 & 15)) * 8) * 2u;
      vvo0 = (unsigned)(drow0 * 512 + (dsl ^ (4 * (drow0 & 3))) * 8) * 2u; vvo1 = (unsigned)(drow1 * 512 + (dsl ^ (4 * (drow1 & 3))) * 8) * 2u; }
    int kro[4], vro[4];
    { const int q_ = (lane & 15) >> 2, p_ = lane & 3, g16 = (lane >> 4) & 1;
#pragma unroll
      for (int d0 = 0; d0 < 4; ++d0) kro[d0] = r * 256 + ((c * 8 + 2 * d0 + h) ^ (r & 15)) * 16;
#pragma unroll
      for (int k = 0; k < 4; ++k) vro[k] = (4 * h + q_) * 256 + (4 * (k ^ q_) + 2 * g16 + (p_ >> 1)) * 16 + 8 * (p_ & 1); }
    for (int it = 0; it < 8; ++it) {
        const int unit = it * 256 + vcu, bh = unit >> 5, qb = unit & 31, b = bh >> 2, hd = bh & 3;
        const size_t tok0 = (size_t)b * SEQ;
        const int q0 = qb * 128 + qw * 32;
        bf16x8 qf[4];
        { const bf16_t* qp = QA + (tok0 + q0 + r) * 512 + hd * 128 + c * 64 + 8 * h;
#pragma unroll
          for (int d0 = 0; d0 < 4; ++d0) qf[d0] = *(const bf16x8*)(qp + 16 * d0); }
        f32x16 o[4], negc;
#pragma unroll
        for (int i = 0; i < 16; ++i) { o[0][i] = 0.f; o[1][i] = 0.f; o[2][i] = 0.f; o[3][i] = 0.f; negc[i] = 0.f; }
        float lsum = 0.f;
        const bf16_t* kgb = KA + tok0 * 512 + hd * 128; const bf16_t* vgb = VA + tok0 * 512 + hd * 128;
#define AT_DMAK(t_) do { const bf16_t* gb_ = kgb + (size_t)(t_) * 64 * 512; const unsigned d_ = (unsigned)__builtin_amdgcn_readfirstlane(lds0 + ((t_) % 3) * AT_KB + dmaoff); glds16(kvo0, gb_, d_); glds16(kvo1, gb_, d_ + 8192u); } while (0)
#define AT_DMAV(t_) do { const bf16_t* gb_ = vgb + (size_t)(t_) * 64 * 512; const unsigned d_ = (unsigned)__builtin_amdgcn_readfirstlane(lds0 + AT_V0 + ((t_) & 1) * AT_VB + dmaoff); glds16(vvo0, gb_, d_); glds16(vvo1, gb_, d_ + 8192u); } while (0)
        AT_DMAK(0); AT_DMAV(0); AT_DMAK(1);
        AT_WAIT_BAR();
        const float bleft = tab[hd * 324 + 0], bright = tab[hd * 324 + 320];
#define AT_CLS(u_) (((u_) * 32 + 31 - q0 <= -91) ? 0 : (((u_) * 32 - (q0 + 31) >= 91) ? 2 : 1))
        int ccls = 1;
#define AT_SETCLS(u_) do { const int nc_ = AT_CLS(u_); if (nc_ != ccls) { const float d_ = (nc_ == 0 ? bleft : (nc_ == 2 ? bright : 0.f)) - (ccls == 0 ? bleft : (ccls == 2 ? bright : 0.f)); \
            _Pragma("unroll") for (int i = 0; i < 16; ++i) negc[i] += d_; ccls = nc_; } } while (0)
#define AT_QK(P, u_) do { LAS const unsigned char* kp_ = lds + ((((u_) >> 1) % 3) * AT_KB + ((u_) & 1) * 8192); \
            { const bf16x8 ka = *(LAS const bf16x8*)(kp_ + kro[0]); P = MFMA32(ka, qf[0], negc); } \
            _Pragma("unroll") for (int d0 = 1; d0 < 4; ++d0) { const bf16x8 ka = *(LAS const bf16x8*)(kp_ + kro[d0]); P = MFMA32(ka, qf[d0], P); } } while (0)
#define AT_HSTEP(A, B, t_, HF) do { const int u_ = 2 * (t_) + (HF); \
            if ((HF) == 0) { if ((t_) + 2 < 64) AT_DMAK((t_) + 2); if ((t_) + 1 < 64) AT_DMAV((t_) + 1); } \
            AT_SETCLS(u_ + 1);                                 \
            if (AT_CLS(u_) == 1) { int rb = u_ * 32 - (q0 + r); asm volatile("" : "+v"(rb));   \
                const LAS float* tp_ = tab + hd * 324 + 160 + rb + 4 * h; \
                _Pragma("unroll") for (int i = 0; i < 16; ++i) A[i] += tp_[(i & 3) + 8 * (i >> 2)]; } \
              \
              \
              \
              \
            AT_QK(B, u_ + 1); \
            f32x16 E; float ls = 0.f; \
            _Pragma("unroll") for (int i = 0; i < 16; ++i) { E[i] = __builtin_amdgcn_exp2f(A[i]); ls += E[i]; } \
            if (u_ == 0 || __any(!(ls <= 256.0f))) { \
                float mx = fmaxf(fmaxf(A[0], A[1]), A[2]); \
                _Pragma("unroll") for (int i = 3; i < 15; i += 2) mx = fmaxf(fmaxf(mx, A[i]), A[i + 1]); \
                mx = xhalf_max(fmaxf(mx, A[15])); \
                const float dl = (u_ == 0) ? mx : fmaxf(mx, 0.f); const float f = __builtin_amdgcn_exp2f(-dl); ls = 0.f; \
                _Pragma("unroll") for (int i = 0; i < 16; ++i) { E[i] = __builtin_amdgcn_exp2f(A[i] - dl); ls += E[i]; B[i] -= dl; negc[i] -= dl; o[0][i] *= f; o[1][i] *= f; o[2][i] *= f; o[3][i] *= f; } \
                lsum *= f; } \
            lsum += ls; \
            { LAS const unsigned char* vb = lds + AT_V0 + ((t_) & 1) * AT_VB + (HF) * 8192; \
              _Pragma("unroll") for (int s = 0; s < 2; ++s) { u32x4 w; \
                  if (s == 0) { w.x = pkbf(E[0], E[1]); w.y = pkbf(E[2], E[3]); w.z = pkbf(E[4], E[5]); w.w = pkbf(E[6], E[7]); } \
                  if (s == 1) { w.x = pkbf(E[8], E[9]); w.y = pkbf(E[10], E[11]); w.z = pkbf(E[12], E[13]); w.w = pkbf(E[14], E[15]); } \
                  const bf16x8 pf = __builtin_bit_cast(bf16x8, w); \
                  _Pragma("unroll") for (int k = 0; k < 4; ++k) { \
                      const s16x4 lo = trrd(vb + vro[k] + (16 * s) * 256), hi = trrd(vb + vro[k] + (16 * s + 8) * 256); \
                      o[k] = MFMA32(cat8(lo, hi), pf, o[k]); } } } \
            if ((HF) == 1) AT_WAIT_BAR(); } while (0)
        f32x16 sA, sB;
#pragma unroll
        for (int i = 0; i < 16; ++i) sB[i] = 0.f;
        AT_SETCLS(0); AT_QK(sA, 0);
        for (int t = 0; t < 64; ++t) { AT_HSTEP(sA, sB, t, 0); AT_HSTEP(sB, sA, t, 1); }
#undef AT_DMAK
#undef AT_DMAV
#undef AT_CLS
#undef AT_SETCLS
#undef AT_QK
#undef AT_HSTEP
        lsum = xhalf_sum(lsum);
        const float inv = __builtin_amdgcn_rcpf(lsum);
        LAS float* X = (LAS float*)lds;
        if (c == 1) { const float f = lam * inv;
#pragma unroll
            for (int k = 0; k < 4; ++k)
#pragma unroll
                for (int i = 0; i < 16; ++i) X[((qw * 4 + k) * 16 + i) * 64 + lane] = o[k][i] * f; }
        __syncthreads();
        if (c == 0) {
            float ss = 0.f;
#pragma unroll
            for (int k = 0; k < 4; ++k)
#pragma unroll
                for (int i = 0; i < 16; ++i) { const float v = o[k][i] * inv - X[((qw * 4 + k) * 16 + i) * 64 + lane]; o[k][i] = v; ss += v * v; }
            ss = xhalf_sum(ss);
            const float rr = rsqrtf(ss * (1.0f / 128.0f) + EPS) * 0.8f;
            bf16_t* op = CAT + (tok0 + q0 + r) * DM + hd * 128;
#pragma unroll
            for (int k = 0; k < 4; ++k)
#pragma unroll
                for (int i4 = 0; i4 < 4; ++i4) { const int d = 32 * k + 8 * i4 + 4 * h; const f32x4 w = *(const f32x4*)(anorm + d);
                    u32x2 ov; ov.x = pkbf(o[k][4 * i4] * rr * w[0], o[k][4 * i4 + 1] * rr * w[1]); ov.y = pkbf(o[k][4 * i4 + 2] * rr * w[2], o[k][4 * i4 + 3] * rr * w[3]);
                    *(u32x2*)(op + d) = ov; }
        }
        { const int c8 = (lane & 15) * 8; const f32x4 w0 = *(const f32x4*)(rnorm + c8), w1 = *(const f32x4*)(rnorm + c8 + 4);
          u32x4 a[4], bq[4], g[4];
#pragma unroll
          for (int i4 = 0; i4 < 4; ++i4) { const size_t ro = (tok0 + qb * 128 + 16 * wid + 4 * i4 + (lane >> 4)) * 512 + hd * 128 + c8;
              a[i4] = __builtin_nontemporal_load((const u32x4*)(OF + ro)); bq[i4] = __builtin_nontemporal_load((const u32x4*)(OB + ro)); g[i4] = __builtin_nontemporal_load((const u32x4*)(GR + ro)); }
#pragma unroll
          for (int i4 = 0; i4 < 4; ++i4) {
              float v[8];
              v[0] = bflo(a[i4].x) + bflo(bq[i4].x); v[1] = bfhi(a[i4].x) + bfhi(bq[i4].x); v[2] = bflo(a[i4].y) + bflo(bq[i4].y); v[3] = bfhi(a[i4].y) + bfhi(bq[i4].y);
              v[4] = bflo(a[i4].z) + bflo(bq[i4].z); v[5] = bfhi(a[i4].z) + bfhi(bq[i4].z); v[6] = bflo(a[i4].w) + bflo(bq[i4].w); v[7] = bfhi(a[i4].w) + bfhi(bq[i4].w);
              float ss = 0.f;
#pragma unroll
              for (int e = 0; e < 8; ++e) ss += v[e] * v[e];
              ss += __shfl_xor(ss, 1); ss += __shfl_xor(ss, 2); ss += __shfl_xor(ss, 4); ss += __shfl_xor(ss, 8);
              const float rq = rsqrtf(ss * (1.0f / 128.0f) + EPS);
              u32x4 ov;
              ov.x = pkbf(v[0] * rq * w0[0] * bflo(g[i4].x), v[1] * rq * w0[1] * bfhi(g[i4].x)); ov.y = pkbf(v[2] * rq * w0[2] * bflo(g[i4].y), v[3] * rq * w0[3] * bfhi(g[i4].y));
              ov.z = pkbf(v[4] * rq * w1[0] * bflo(g[i4].z), v[5] * rq * w1[1] * bfhi(g[i4].z)); ov.w = pkbf(v[6] * rq * w1[2] * bflo(g[i4].w), v[7] * rq * w1[3] * bfhi(g[i4].w));
              *(u32x4*)(CAT + (tok0 + qb * 128 + 16 * wid + 4 * i4 + (lane >> 4)) * DM + 512 + hd * 128 + c8) = ov;
          } }
        __syncthreads();
    }
}

constexpr int HG_P = 272, HG_KDP = 320, HG_VP = 192, HG_ASP = 144;
constexpr int HG_QI = 0, HG_KI = 64 * HG_P, HG_QG = 2 * 64 * HG_P, HG_KD = 3 * 64 * HG_P, HG_V = HG_KD + 64 * HG_KDP, HG_AS = HG_V + 64 * HG_VP, HG_ST = HG_AS + 64 * HG_ASP,
              HG_EGL = HG_ST + 64 * HG_P, HG_SEG = HG_EGL + 512, HG_END = HG_SEG + 8 * 128 * 4;
static_assert(HG_END <= 131072 && 131072 + 12288 + 4096 <= LDS_BYTES, "hgrn lds / epilogue tables");
__device__ __forceinline__ void hgrn_phase(LAS unsigned char* lds, const bf16_t* mix, bf16_t* OFB, int item) {
    int tid = threadIdx.x; asm volatile("" : "+v"(tid));
    const int lane = tid & 63, wid = __builtin_amdgcn_readfirstlane(tid >> 6), r = lane & 31, h = lane >> 5;
    const int dvh = item & 1, dir = (item >> 1) & 1, hh = (item >> 2) & 3, b = item >> 4;
    const bf16_t* QR = mix + (size_t)MB_QR * MIXSZ; const bf16_t* IR = mix + (size_t)MB_IR * MIXSZ;
    const bf16_t* KK = mix + (size_t)(MB_KF + 2 * dir) * MIXSZ;
    bf16_t* O = OFB + (size_t)dir * MIXSZ;
    const size_t tok0 = (size_t)b * SEQ;
    for (int e = tid; e < 64 * HG_P / 4; e += 512) ((LAS unsigned*)(lds + HG_ST))[e] = 0u;
    f32x16 sacc;
#pragma unroll
    for (int i = 0; i < 16; ++i) sacc[i] = 0.f;
    const int tv = tid >> 3, cv = tid & 7;
    const int trr = 8 * h + ((lane & 15) >> 2), trc = ((lane >> 4) & 1) * 16 + (lane & 3) * 4;
    unsigned cq[8], ck[8]; u32x4 cvv;
#define HG_BAR() asm volatile("s_waitcnt lgkmcnt(0)\n\ts_barrier" ::: "memory")
#define HG_TOK(c_, t_) (dir ? (SEQ - 1 - ((c_) * 64 + (t_))) : ((c_) * 64 + (t_)))
#define HG_LOAD(c_, q_, k_, v_) do { _Pragma("unroll") for (int j = 0; j < 8; ++j) { const size_t off = (tok0 + HG_TOK(c_, 8 * wid + j)) * 512 + hh * 128 + 2 * lane; \
        q_[j] = *(const unsigned*)(QR + off); k_[j] = *(const unsigned*)(KK + off); } \
        v_ = *(const u32x4*)(IR + (tok0 + HG_TOK(c_, tv)) * 512 + hh * 128 + dvh * 64 + cv * 8); } while (0)
    HG_LOAD(0, cq, ck, cvv);
    __syncthreads();
    for (int c = 0; c < 64; ++c) {
        float c0[8], c1[8];
        { float a0 = 0.f, a1 = 0.f;
#pragma unroll
          for (int j = 0; j < 8; ++j) { a0 += __logf(1.0f - bflo(ck[j])); a1 += __logf(1.0f - bfhi(ck[j])); c0[j] = a0; c1[j] = a1; } }
        *(LAS f32x2*)(lds + HG_SEG + (wid * 128 + 2 * lane) * 4) = (f32x2){c0[7], c1[7]};
        unsigned nq[8], nk[8]; u32x4 nv;
        { const int cn = (c + 1 < 64) ? c + 1 : 63; HG_LOAD(cn, nq, nk, nv); }
        HG_BAR();
        float pre0 = 0.f, pre1 = 0.f, mid0 = 0.f, mid1 = 0.f, last0 = 0.f, last1 = 0.f;
#pragma unroll
        for (int s = 0; s < 8; ++s) { const f32x2 tt = *(LAS const f32x2*)(lds + HG_SEG + (s * 128 + 2 * lane) * 4);
            if (s < wid) { pre0 += tt[0]; pre1 += tt[1]; } if (s < 4) { mid0 += tt[0]; mid1 += tt[1]; } last0 += tt[0]; last1 += tt[1]; }
        const float eM0 = __expf(mid0), eM1 = __expf(mid1), eL0 = __expf(last0 - mid0), eL1 = __expf(last1 - mid1);
#pragma unroll
        for (int j = 0; j < 8; ++j) {
            const float e10 = __expf(pre0 + c0[j] - mid0), e11 = __expf(pre1 + c1[j] - mid1);
            const float e20 = __builtin_amdgcn_rcpf(e10), e21 = __builtin_amdgcn_rcpf(e11);
            const float qi0 = bflo(cq[j]) * e10, qi1 = bfhi(cq[j]) * e11, ki0 = bflo(ck[j]) * e20, ki1 = bfhi(ck[j]) * e21;
            const int ro = (8 * wid + j), co = 4 * lane;
            *(LAS unsigned*)(lds + HG_QI + ro * HG_P + co) = pkbf(qi0, qi1);
            *(LAS unsigned*)(lds + HG_KI + ro * HG_P + co) = pkbf(ki0, ki1);
            *(LAS unsigned*)(lds + HG_QG + ro * HG_P + co) = pkbf(qi0 * eM0, qi1 * eM1);
            *(LAS unsigned*)(lds + HG_KD + ro * HG_KDP + co) = pkbf(ki0 * eL0, ki1 * eL1);
        }
        *(LAS u32x4*)(lds + HG_V + tv * HG_VP + cv * 16) = cvv;
        if (wid == 0) *(LAS f32x2*)(lds + HG_EGL + 8 * lane) = (f32x2){__expf(last0), __expf(last1)};
        HG_BAR();
        f32x16 oacc;
#pragma unroll
        for (int i = 0; i < 16; ++i) oacc[i] = 0.f;
        const int tb = (wid & 3) >> 1, xb = wid & 1;
        if (wid < 4) {
            if (xb <= tb) {
                f32x16 a;
#pragma unroll
                for (int i = 0; i < 16; ++i) a[i] = 0.f;
#pragma unroll
                for (int kh = 0; kh < 2; ++kh) { bf16x8 A[4], B[4];
#pragma unroll
                    for (int ks = 0; ks < 4; ++ks) { A[ks] = *(LAS const bf16x8*)(lds + HG_QI + (32 * tb + r) * HG_P + (16 * (4 * kh + ks) + 8 * h) * 2);
                        B[ks] = *(LAS const bf16x8*)(lds + HG_KI + (32 * xb + r) * HG_P + (16 * (4 * kh + ks) + 8 * h) * 2); }
#pragma unroll
                    for (int ks = 0; ks < 4; ++ks) a = MFMA32(A[ks], B[ks], a);
                }
#pragma unroll
                for (int i = 0; i < 16; ++i) { const int t = 32 * tb + crow(i, h), s = 32 * xb + r; const float v = (s <= t) ? a[i] : 0.f;
                    *(LAS bf16_t*)(lds + HG_AS + t * HG_ASP + s * 2) = (bf16_t)(pkbf(v, v) & 0xffffu); }
            }
        } else {
#pragma unroll
            for (int kh = 0; kh < 2; ++kh) { bf16x8 A[4], B[4];
#pragma unroll
                for (int ks = 0; ks < 4; ++ks) { A[ks] = *(LAS const bf16x8*)(lds + HG_QG + (32 * tb + r) * HG_P + (16 * (4 * kh + ks) + 8 * h) * 2);
                    B[ks] = *(LAS const bf16x8*)(lds + HG_ST + (32 * xb + r) * HG_P + (16 * (4 * kh + ks) + 8 * h) * 2); }
#pragma unroll
                for (int ks = 0; ks < 4; ++ks) oacc = MFMA32(A[ks], B[ks], oacc);
            }
        }
        HG_BAR();
        if (wid >= 4) {
            const int nks = 2 * (tb + 1);
            for (int ks = 0; ks < nks; ++ks) {
                const bf16x8 A = *(LAS const bf16x8*)(lds + HG_AS + (32 * tb + r) * HG_ASP + (16 * ks + 8 * h) * 2);
                LAS const unsigned char* vp = lds + HG_V + (16 * ks + trr) * HG_VP + (32 * xb + trc) * 2;
                const s16x4 lo = trrd(vp), hi = trrd(vp + 4 * HG_VP);
                oacc = MFMA32(A, cat8(lo, hi), oacc);
            }
#pragma unroll
            for (int i = 0; i < 16; ++i) { const int t = 32 * tb + crow(i, h);
                O[(tok0 + HG_TOK(c, t)) * 512 + hh * 128 + dvh * 64 + 32 * xb + r] = (bf16_t)(pkbf(oacc[i], oacc[i]) & 0xffffu); }
        }
        { const int kb = wid >> 1, vb = wid & 1;
#pragma unroll
          for (int i4 = 0; i4 < 4; ++i4) { const f32x4 eg = *(LAS const f32x4*)(lds + HG_EGL + (32 * kb + 8 * i4 + 4 * h) * 4);
              sacc[4 * i4] *= eg[0]; sacc[4 * i4 + 1] *= eg[1]; sacc[4 * i4 + 2] *= eg[2]; sacc[4 * i4 + 3] *= eg[3]; }
          { bf16x8 Af[4], Bf[4];
#pragma unroll
            for (int ks = 0; ks < 4; ++ks) {
                LAS const unsigned char* ap = lds + HG_KD + (16 * ks + trr) * HG_KDP + (32 * kb + trc) * 2;
                LAS const unsigned char* bp = lds + HG_V + (16 * ks + trr) * HG_VP + (32 * vb + trc) * 2;
                Af[ks] = cat8(trrd(ap), trrd(ap + 4 * HG_KDP)); Bf[ks] = cat8(trrd(bp), trrd(bp + 4 * HG_VP)); }
#pragma unroll
            for (int ks = 0; ks < 4; ++ks) sacc = MFMA32(Af[ks], Bf[ks], sacc); }
#pragma unroll
          for (int i4 = 0; i4 < 4; ++i4) { u32x2 w; w.x = pkbf(sacc[4 * i4], sacc[4 * i4 + 1]); w.y = pkbf(sacc[4 * i4 + 2], sacc[4 * i4 + 3]);
              *(LAS u32x2*)(lds + HG_ST + (32 * vb + r) * HG_P + (32 * kb + 8 * i4 + 4 * h) * 2) = w; } }
#pragma unroll
        for (int j = 0; j < 8; ++j) { cq[j] = nq[j]; ck[j] = nk[j]; }
        cvv = nv;
    }
    __syncthreads();
#undef HG_BAR
#undef HG_TOK
#undef HG_LOAD
}

#define XB_TMO      128
#define XB_XCNT(j)  (256  + 64 * (j))
#define XB_XSUB(j)  (1280 + 64 * (j))
#define XB_XGEN(j)  (2304 + 64 * (j))
#define XB_TOP      3328
#define XB_TOPGEN   3392
#define XCD_BAR_WORDS 3456
#define XB_SPIN_CAP (1u << 18)

__device__ __forceinline__ unsigned xb_ld(unsigned* p)              { return __hip_atomic_load(p, __ATOMIC_RELAXED, __HIP_MEMORY_SCOPE_AGENT); }
__device__ __forceinline__ unsigned xb_add(unsigned* p, unsigned v) { return __hip_atomic_fetch_add(p, v, __ATOMIC_RELAXED, __HIP_MEMORY_SCOPE_AGENT); }
__device__ __forceinline__ unsigned xb_xcc_id() { return (unsigned)__builtin_amdgcn_s_getreg((3 << 11) | 20) & 0xFu; }
#define XB_SPIN(cond, bar) do { unsigned _sp = 0; while (cond) { __builtin_amdgcn_s_sleep(1); \
    if ((++_sp & 255u) == 0u) { if (xb_ld(&(bar)[XB_TMO])) break; if (_sp > XB_SPIN_CAP) { atomicAdd(&(bar)[XB_TMO], 1u); break; } } } } while (0)

struct XcdBarrier {
    unsigned* bar; unsigned x;
    volatile LAS unsigned* st;
};

__device__ __forceinline__ XcdBarrier xcd_barrier_post(unsigned* bar, volatile LAS unsigned* st) {
    XcdBarrier b; b.bar = bar; b.x = xb_xcc_id(); b.st = st;
    if (threadIdx.x == 0) (void)xb_add(&bar[XB_XCNT(b.x)], 1u);
    return b;
}
__device__ __forceinline__ void xcd_barrier_complete(unsigned* bar, unsigned x, unsigned& nloc, unsigned& nx) {
    const unsigned G = gridDim.x * gridDim.y * gridDim.z;
    unsigned sum, cnt, mine, sp = 0u;
    for (;;) {
        sum = 0u; cnt = 0u; mine = 0u;
#pragma unroll
        for (unsigned j = 0; j < 16; ++j) { const unsigned c = xb_ld(&bar[XB_XCNT(j)]); sum += c; cnt += (c > 0u) ? 1u : 0u; mine = (j == x) ? c : mine; }
        if (sum == G) break;
        __builtin_amdgcn_s_sleep(1);
        if ((++sp & 255u) == 0u) { if (xb_ld(&bar[XB_TMO])) break; if (sp > XB_SPIN_CAP) { atomicAdd(&bar[XB_TMO], 1u); break; } }
    }
    nloc = mine > 0u ? mine : 1u; nx = cnt > 0u ? cnt : 1u;
}

__device__ __forceinline__ void xcd_barrier(const XcdBarrier& b) {
    asm volatile("s_waitcnt vmcnt(0)" ::: "memory");
    __syncthreads();
    if (threadIdx.x == 0) {
        unsigned* bar = b.bar;
        __builtin_amdgcn_s_waitcnt(0);
        unsigned nloc = b.st[0], nx = b.st[1];
        if (nloc == 0u) { xcd_barrier_complete(bar, b.x, nloc, nx); b.st[0] = nloc; b.st[1] = nx; }
        const unsigned old = xb_add(&bar[XB_XSUB(b.x)], 1u);
        const unsigned gen = old / nloc;
        if (old + 1u == (gen + 1u) * nloc) {
            __builtin_amdgcn_fence(__ATOMIC_RELEASE, "agent");
            asm volatile("s_waitcnt vmcnt(0)" ::: "memory");
            const unsigned og = xb_add(&bar[XB_TOP], 1u);
            const unsigned tg = og / nx;
            if (og + 1u == (tg + 1u) * nx) xb_add(&bar[XB_TOPGEN], 1u);
            else XB_SPIN(xb_ld(&bar[XB_TOPGEN]) == tg, bar);
            __builtin_amdgcn_fence(__ATOMIC_ACQUIRE, "agent");
            xb_add(&bar[XB_XGEN(b.x)], 1u);
            asm volatile("s_waitcnt vmcnt(0)" ::: "memory");
        } else {
            XB_SPIN(xb_ld(&bar[XB_XGEN(b.x)]) == gen, bar);
            __builtin_amdgcn_fence(__ATOMIC_ACQUIRE, "agent");
            asm volatile("s_waitcnt vmcnt(0)" ::: "memory");
        }
    }
    __syncthreads();
}

struct Params { const float* in[21]; float* out; unsigned char* ws; };
template <int LO, int HI>
__global__ void __launch_bounds__(512, 2) mega(Params p) {
    extern __shared__ __attribute__((aligned(16))) unsigned char lds_raw[];
    LAS unsigned char* lds = (LAS unsigned char*)lds_raw;
    const int tid = threadIdx.x, lane = tid & 63, wid = __builtin_amdgcn_readfirstlane(tid >> 6);
    const int G = gridDim.x, bx = blockIdx.x;
    const int vcu = (G % 8 == 0) ? (bx % 8) * (G / 8) + bx / 8 : bx;
    const int gw = vcu * 8 + wid, ngw = G * 8;
    unsigned char* ws = p.ws;
    bf16_t* W1in = (bf16_t*)(ws + WS_W1IN); bf16_t* W1out = (bf16_t*)(ws + WS_W1OUT); bf16_t* Wmin = (bf16_t*)(ws + WS_WMIN); bf16_t* Wmout = (bf16_t*)(ws + WS_WMOUT);
    bf16_t* W2in = (bf16_t*)(ws + WS_W2IN); bf16_t* W2out = (bf16_t*)(ws + WS_W2OUT);
    float* part = (float*)(ws + WS_PART); bf16_t* XN = (bf16_t*)(ws + WS_XN); bf16_t* Y = (bf16_t*)(ws + WS_Y); bf16_t* BIG = (bf16_t*)(ws + WS_BIG);
    const float* x = p.in[0]; float* out = p.out;

#define IN(k) (LO <= (k) && (k) < HI)
    volatile LAS unsigned* bst = (volatile LAS unsigned*)(lds + 131072 + 6144);
    if (tid < 2) bst[tid] = 0u;
    __syncthreads();
    XcdBarrier xbar; xbar.bar = (unsigned*)ws + CTL_BAR; xbar.x = 0; xbar.st = bst;
#define GSYNC(k) do { if constexpr (IN(k) && IN((k) + 1)) xcd_barrier(xbar); } while (0)
    unsigned* ctl = (unsigned*)ws;
    float* xb = (float*)(ws + WS_XB);
    LAS unsigned char* xl = lds + 131072;
    for (int e = bx * 512 + tid; e < CTL_BAR + XCD_BAR_WORDS; e += G * 512) ctl[e] = 0u;
    cg::this_grid().sync();
    xbar = xcd_barrier_post((unsigned*)ws + CTL_BAR, bst);
    if constexpr (IN(0)) {
        LAS float* scr = (LAS float*)(lds + wid * 16384);
        constexpr int I_IN = (DM / 64) * (2 * FF / 32), I_OUT = (FF / 64) * (DM / 32), I_MI = (DM / 64) * (4096 / 32), I_MO = (DM / 64) * (DM / 32);
        constexpr int NIT = 2 * I_IN + 2 * I_OUT + I_MI + I_MO;
        for (int it = gw; it < NIT; it += ngw) {
            int q = it;
            if (q < I_IN) { transpose_item<1>(p.in[4], DM, 2 * FF, W1in, scr, q, lane, p.in[3]); continue; } q -= I_IN;
            if (q < I_IN) { transpose_item<1>(p.in[18], DM, 2 * FF, W2in, scr, q, lane, p.in[17]); continue; } q -= I_IN;
            if (q < I_OUT) { transpose_item<0>(p.in[5], FF, DM, W1out, scr, q, lane, nullptr); continue; } q -= I_OUT;
            if (q < I_OUT) { transpose_item<0>(p.in[19], FF, DM, W2out, scr, q, lane, nullptr); continue; } q -= I_OUT;
            if (q < I_MI) { transpose_item<2>(p.in[8], DM, 4096, Wmin, scr, q, lane, p.in[7]); continue; } q -= I_MI;
            transpose_item<0>(p.in[15], DM, DM, Wmout, scr, q, lane, nullptr);
        }
        if (bx == 0) for (int e = tid; e < 1024; e += 512) { const int d = e >> 9, cc = e & 511; const float l0 = p.in[2][d * 1024 + cc], l1 = p.in[2][d * 1024 + 512 + cc];
            ((float*)(ws + WS_LB))[e] = 1.0f / (1.0f + __expf(l1 - l0)); }
        norm_rows<false, false, true>(gw, ngw, lane, x, nullptr, nullptr, nullptr, 0.f, part, nullptr, XN);
    }
    GSYNC(0);
    if constexpr (IN(1)) {
        LAS float* rsl = (LAS float*)(lds + 131072 + 8192); fill_row_scales(rsl, part, bx, tid);
        pg8::Gemm g{XN, W1in, M, 2 * FF, DM}; pg8::StaticOrder S; S.init(M, 2 * FF, G, bx); EpiSwiglu E{BIG, rsl};
        pg8::gemm_phase<EpiSwiglu, pg8::StaticOrder, true, true>(lds, g, S, E);
    }
    GSYNC(1);
    if constexpr (IN(2)) {
        pg8::Gemm g{BIG, W1out, M, DM, FF}; pg8::StaticOrder S; S.init(M, DM, G, bx);
        LAS float* wl = (LAS float*)(lds + 131072 + 8192); stage_gain(wl, p.in[6], tid);
        EpiResNorm<false, true> E{XN, nullptr, wl, 0.5f, XN, part, xb, ctl, xl};
        pg8::gemm_phase<EpiResNorm<false, true>, pg8::StaticOrder, true, true>(lds, g, S, E);
    }
    GSYNC(2);
    if constexpr (IN(3)) {
        LAS float* rsl = (LAS float*)(lds + 131072 + 8192); fill_row_scales(rsl, part, bx, tid);
        LAS float* lbs = (LAS float*)(lds + 131072 + 12288); stage_gain(lbs, (const float*)(ws + WS_LB), tid);
        pg8::Gemm g{XN, Wmin, M, 4096, DM}; pg8::StaticOrder S; S.init(M, 4096, G, bx); EpiMix E{BIG, lbs, rsl};
        pg8::gemm_phase<EpiMix, pg8::StaticOrder, true, true>(lds, g, S, E);
    }
    GSYNC(3);
    if constexpr (IN(4)) {
        for (int item = vcu; item < 256; item += G) hgrn_phase(lds, BIG, Y, item);
    }
    GSYNC(4);
    bf16_t* CAT = BIG + (size_t)MB_QR * MIXSZ;
    if constexpr (IN(5)) {
        attn_phase(lds, BIG + (size_t)MB_QA * MIXSZ, BIG + (size_t)MB_KA * MIXSZ, BIG + (size_t)MB_VA * MIXSZ, CAT, Y, Y + MIXSZ, BIG + (size_t)MB_GR * MIXSZ, p.in[14],
                   p.in[1], p.in[9], p.in[10], p.in[11], p.in[12], p.in[13], vcu);
    }
    GSYNC(5);
    bf16_t* XN2 = (bf16_t*)(ws + WS_XN2);
    if constexpr (IN(6)) {
        pg8::Gemm g{CAT, Wmout, M, DM, DM}; pg8::StaticOrder S; S.init(M, DM, G, bx);
        LAS float* wl = (LAS float*)(lds + 131072 + 8192); stage_gain(wl, p.in[16], tid);
        EpiResNorm<false, true> E{XN, nullptr, wl, 1.0f, XN2, part, xb + 262144, ctl + 256 * 64, xl};
        pg8::gemm_phase<EpiResNorm<false, true>, pg8::StaticOrder, true, true>(lds, g, S, E);
    }
    GSYNC(6);
    if constexpr (IN(7)) {
        LAS float* rsl = (LAS float*)(lds + 131072 + 8192); fill_row_scales(rsl, part, bx, tid);
        pg8::Gemm g{XN2, W2in, M, 2 * FF, DM}; pg8::StaticOrder S; S.init(M, 2 * FF, G, bx); EpiSwiglu E{BIG, rsl};
        pg8::gemm_phase<EpiSwiglu, pg8::StaticOrder, true, true>(lds, g, S, E);
    }
    GSYNC(7);
    if constexpr (IN(8)) {
        pg8::Gemm g{BIG, W2out, M, DM, FF}; pg8::StaticOrder S; S.init(M, DM, G, bx);
        LAS float* wl = (LAS float*)(lds + 131072 + 8192); stage_gain(wl, p.in[20], tid);
        EpiResNorm<true, true> E{XN2, out, wl, 0.5f, nullptr, nullptr, xb + 2 * 262144, ctl + 2 * 256 * 64, xl};
        pg8::gemm_phase<EpiResNorm<true, true>, pg8::StaticOrder, true, true>(lds, g, S, E);
    }
#undef IN
#undef GSYNC
}

extern "C" void kernel_launch(void* const* d_in, const int* in_sizes, int n_in, void* d_out, int out_size, void* d_ws, size_t ws_size, hipStream_t stream) {
    static int grid = 0;
    if (grid == 0) {
        if (n_in != 21 || out_size != M * DM || ws_size < 960 * MiB) { fprintf(stderr, "kernel_launch: unexpected shapes (n_in %d out %d ws %zu)\n", n_in, out_size, ws_size); grid = -1; return; }
        int dev = 0, cus = 0, per_cu = 0;
        (void)hipGetDevice(&dev); (void)hipDeviceGetAttribute(&cus, hipDeviceAttributeMultiprocessorCount, dev);
        if (hipFuncSetAttribute((const void*)mega<0, 9>, hipFuncAttributeMaxDynamicSharedMemorySize, LDS_BYTES) != hipSuccess) { fprintf(stderr, "kernel_launch: hipFuncSetAttribute failed\n"); grid = -1; return; }
        if (hipOccupancyMaxActiveBlocksPerMultiprocessor(&per_cu, (const void*)mega<0, 9>, 512, LDS_BYTES) != hipSuccess || per_cu < 1) fprintf(stderr, "kernel_launch: occupancy query says %d\n", per_cu);
        (void)hipGetLastError();
        grid = cus > 0 ? cus : 256;
        if (grid != 256) fprintf(stderr, "kernel_launch: %d CUs: the fused row-statistics exchange assumes 256 workgroups\n", grid);
    }
    if (grid < 0) return;
    Params p{};
    for (int i = 0; i < 21; ++i) p.in[i] = (const float*)d_in[i];
    p.out = (float*)d_out; p.ws = (unsigned char*)d_ws;
    void* args[] = {&p};
    hipError_t e = hipLaunchCooperativeKernel((const void*)mega<0, 9>, dim3(grid), dim3(512), args, LDS_BYTES, stream);
    if (e != hipSuccess) fprintf(stderr, "kernel_launch: cooperative launch failed: %s (grid %d)\n", hipGetErrorString(e), grid);
}
```

```cpp
#include <hip/hip_runtime.h>
#include <hip/hip_cooperative_groups.h>
#include <cstdio>
#include <cstdint>
namespace cg = cooperative_groups;
namespace pg8 {
#define PG8_LAS __attribute__((address_space(3)))
typedef unsigned short bf16_t;
typedef short bf16x8 __attribute__((ext_vector_type(8)));
typedef float f32x4 __attribute__((ext_vector_type(4)));
typedef unsigned u32x4 __attribute__((ext_vector_type(4)));
constexpr int BM = 256, BK = 64, HALF = 128, HTB = HALF * BK * 2  , STAGE_BYTES = 8 * HTB, NXCD = 8, WGM = 8;

__host__ __device__ __forceinline__ int lds_byte(int r, int c) { const int st = (r >> 4) * 2 + (c >> 5), rr = r & 15, cc = c & 31, ob = rr * 64 + cc * 2; return st * 1024 + (ob ^ (((ob >> 9) & 1) << 5)); }
__host__ __device__ __forceinline__ void stage_rc(int b, int& R, int& C) { const int st = b / 1024, sb = b % 1024, swz = sb ^ (((sb >> 9) & 1) << 5); R = (st >> 1) * 16 + swz / 64; C = (st & 1) * 32 + (swz % 64) / 2; }
__host__ __device__ __forceinline__ int perm32(int rho) { const int n = rho >> 4, i = rho & 15; return 8 * (i >> 2) + 4 * n + (i & 3); }

struct Unit { int pm, pn; };
struct Gemm { const bf16_t* A; const bf16_t* Bt; int M, N, K; };

struct StaticOrder {
    int nM, nN, nwg, G, c;
    __host__ __device__ void init(int M, int N, int G_, int c_) { nM = M / BM; nN = N / BM; nwg = nM * nN; G = G_; c = c_; }
    __host__ __device__ bool next(int i, Unit& u) const {
        const long L = (long)i * G + c; if (L >= nwg) return false;
        int wgid = (int)L; { const int q = nwg / NXCD, r = nwg % NXCD, xcd = wgid % NXCD, off = wgid / NXCD; wgid = (xcd < r ? xcd * (q + 1) : r * (q + 1) + (xcd - r) * q) + off; }
        const int nig = WGM * nN, gid = wgid / nig, fm = gid * WGM, gsz = (nM - fm) < WGM ? (nM - fm) : WGM;
        u.pm = fm + ((wgid % nig) % gsz); u.pn = (wgid % nig) / gsz; return true;
    }
    __device__ __forceinline__ void a_ready(const Unit&) const {}
    __device__ __forceinline__ void done(const Unit&) const {}
};

__device__ __forceinline__ unsigned cvt_pk_bf16(float lo, float hi) { unsigned r; asm volatile("v_cvt_pk_bf16_f32 %0, %1, %2" : "=v"(r) : "v"(lo), "v"(hi)); return r; }
typedef float f32x2 __attribute__((ext_vector_type(2)));
template <class Epi, class Sched, bool ALIGN_EPI = false, bool SP2 = false>
__device__ __forceinline__ void gemm_phase(PG8_LAS unsigned char* lds, const Gemm g, const Sched& S, const Epi& E) {
    int tid = threadIdx.x; asm volatile("" : "+v"(tid));
    const int wid = __builtin_amdgcn_readfirstlane(tid >> 6), lane = tid & 63, wr = wid >> 2, wc = wid & 3, fr = lane & 15, fq = lane >> 4;
    const int K = g.K, nt = K / BK;
    unsigned voffA[2], voffB[2];
#pragma unroll
    for (int i = 0; i < 2; ++i) { int R, C; stage_rc(tid * 16 + i * 8192, R, C); const int Rb = Epi::PERM ? ((R & ~31) + perm32(R & 31)) : R;
        voffA[i] = (unsigned)(R * K + C) * 2u; voffB[i] = (unsigned)(Rb * K + C) * 2u; }
    const size_t kstep = (size_t)(BK * 2);
    const size_t hstep = (size_t)HALF * K * 2;
    const size_t tstep = 2 * hstep;
    const unsigned ldsw = (unsigned)wid * 1024u;
    const int aoff = lds_byte(wr * 64 + fr, fq * 8), boff = lds_byte(wc * 32 + fr, fq * 8);
#define PG8_SA(b, h) (((b) * 2 + (h)) * HTB)
#define PG8_SB(b, h) ((4 + (b) * 2 + (h)) * HTB)
#define PG8_STAGE(bufoff, gbase, voff) do { _Pragma("unroll") for (int _i = 0; _i < 2; ++_i) \
        __builtin_amdgcn_global_load_lds((const unsigned*)((const char*)(gbase) + (voff)[_i]), (PG8_LAS unsigned*)(lds + (bufoff) + ldsw + _i * 8192), 16, 0, 0); } while (0)
#define PG8_LDA(dst, b, h) do { _Pragma("unroll") for (int m = 0; m < 4; ++m) _Pragma("unroll") for (int k = 0; k < 2; ++k) dst[m][k] = *(const PG8_LAS bf16x8*)(lds + PG8_SA(b, h) + aoff + m * 2048 + k * 1024); } while (0)
#define PG8_LDB(dst, b, h) do { _Pragma("unroll") for (int n = 0; n < 2; ++n) _Pragma("unroll") for (int k = 0; k < 2; ++k) dst[n][k] = *(const PG8_LAS bf16x8*)(lds + PG8_SB(b, h) + boff + n * 2048 + k * 1024); } while (0)
#define PG8_MMA(ai, bj, At, Bt) do { __builtin_amdgcn_s_setprio(1); _Pragma("unroll") for (int m = 0; m < 4; ++m) _Pragma("unroll") for (int n = 0; n < 2; ++n) _Pragma("unroll") for (int k = 0; k < 2; ++k) \
        acc[ai][bj][m][n] = __builtin_amdgcn_mfma_f32_16x16x32_bf16(Bt[n][k], At[m][k], acc[ai][bj][m][n], 0, 0, 0); __builtin_amdgcn_s_setprio(0); } while (0)
#define PG8_WAIT_V(n) asm volatile("s_waitcnt vmcnt(" #n ")" ::: "memory")
#define PG8_WAIT_L(n) asm volatile("s_waitcnt lgkmcnt(" #n ")" ::: "memory")
#define PG8_BAR __builtin_amdgcn_s_barrier()
#define PG8_SCHED __builtin_amdgcn_sched_barrier(0)
    Unit cur, nxt; int ui = 0;
    if (!S.next(0, cur)) return;
    f32x4 acc[2][2][4][2];
#pragma unroll
    for (int a = 0; a < 2; ++a)
#pragma unroll
        for (int b = 0; b < 2; ++b)
#pragma unroll
            for (int m = 0; m < 4; ++m)
#pragma unroll
                for (int n = 0; n < 2; ++n) acc[a][b][m][n] = (f32x4){0.f, 0.f, 0.f, 0.f};
    bf16x8 At[4][2], B0[2][2], B1[2][2];
    const char* cA = (const char*)g.A + (size_t)cur.pm * tstep; const char* cB = (const char*)g.Bt + (size_t)cur.pn * tstep;
    S.a_ready(cur);
    if constexpr (SP2) {
        PG8_STAGE(PG8_SB(0, 0), cB, voffB); PG8_STAGE(PG8_SB(0, 1), cB + hstep, voffB); PG8_STAGE(PG8_SA(0, 0), cA, voffA); PG8_STAGE(PG8_SA(0, 1), cA + hstep, voffA);
        if (wr == 1) PG8_BAR;
        PG8_WAIT_V(2); PG8_BAR;
        PG8_STAGE(PG8_SB(1, 0), cB + kstep, voffB); PG8_STAGE(PG8_SA(1, 0), cA + kstep, voffA); PG8_STAGE(PG8_SB(1, 1), cB + hstep + kstep, voffB);
        PG8_WAIT_V(6); PG8_BAR;
    } else {
        PG8_STAGE(PG8_SB(0, 0), cB, voffB); PG8_STAGE(PG8_SA(0, 0), cA, voffA); PG8_STAGE(PG8_SB(0, 1), cB + hstep, voffB); PG8_STAGE(PG8_SA(0, 1), cA + hstep, voffA);
        if (wr == 1) PG8_BAR;
        PG8_WAIT_V(4); PG8_BAR;
        PG8_STAGE(PG8_SB(1, 0), cB + kstep, voffB); PG8_STAGE(PG8_SA(1, 0), cA + kstep, voffA); PG8_STAGE(PG8_SB(1, 1), cB + hstep + kstep, voffB);
        PG8_WAIT_V(6); PG8_BAR;
    }
    for (;;) {
        const bool has_next = S.next(ui + 1, nxt);
        const char* nA = has_next ? (const char*)g.A + (size_t)nxt.pm * tstep : cA; const char* nB = has_next ? (const char*)g.Bt + (size_t)nxt.pn * tstep : cB;
        for (int t = 0; t < nt; t += 2) {
            const bool last = (t == nt - 2);
            const char* a1 = cA + (size_t)(t + 1) * kstep;
            const char* a2 = last ? nA : cA + (size_t)(t + 2) * kstep; const char* b2 = last ? nB : cB + (size_t)(t + 2) * kstep;
            const char* a3 = a2 + kstep; const char* b3 = b2 + kstep;
            if (last && has_next) S.a_ready(nxt);
            if constexpr (SP2) {
            PG8_LDB(B0, 0, 0); PG8_LDB(B1, 0, 1); PG8_SCHED; PG8_LDA(At, 0, 0); PG8_STAGE(PG8_SA(1, 1), a1 + hstep, voffA);
            PG8_WAIT_V(8); PG8_WAIT_L(0); PG8_BAR; PG8_MMA(0, 0, At, B0); PG8_MMA(0, 1, At, B1); PG8_BAR; PG8_SCHED;
            PG8_LDA(At, 0, 1); PG8_STAGE(PG8_SB(0, 0), b2, voffB); PG8_STAGE(PG8_SB(0, 1), b2 + hstep, voffB); PG8_STAGE(PG8_SA(0, 0), a2, voffA);
            PG8_WAIT_V(8); PG8_WAIT_L(0); PG8_BAR; PG8_MMA(1, 0, At, B0); PG8_MMA(1, 1, At, B1); PG8_BAR; PG8_SCHED;
            PG8_LDB(B0, 1, 0); PG8_LDB(B1, 1, 1); PG8_SCHED; PG8_LDA(At, 1, 0); PG8_STAGE(PG8_SA(0, 1), a2 + hstep, voffA);
            PG8_WAIT_V(8); PG8_WAIT_L(0); PG8_BAR; PG8_MMA(0, 0, At, B0); PG8_MMA(0, 1, At, B1); PG8_BAR; PG8_SCHED;
            PG8_LDA(At, 1, 1); PG8_STAGE(PG8_SB(1, 0), b3, voffB); PG8_STAGE(PG8_SB(1, 1), b3 + hstep, voffB); PG8_STAGE(PG8_SA(1, 0), a3, voffA);
            PG8_WAIT_V(8); PG8_WAIT_L(0); PG8_BAR; PG8_MMA(1, 0, At, B0); PG8_MMA(1, 1, At, B1); PG8_BAR; PG8_SCHED;
            } else {
            PG8_LDB(B0, 0, 0); PG8_SCHED; PG8_LDA(At, 0, 0); PG8_STAGE(PG8_SA(1, 1), a1 + hstep, voffA);
            PG8_WAIT_L(8); PG8_BAR; PG8_WAIT_L(0); PG8_MMA(0, 0, At, B0); PG8_BAR; PG8_SCHED;
            PG8_LDB(B1, 0, 1); PG8_STAGE(PG8_SB(0, 0), b2, voffB);
            PG8_BAR; PG8_WAIT_L(0); PG8_MMA(0, 1, At, B1); PG8_BAR;
            PG8_LDA(At, 0, 1); PG8_STAGE(PG8_SA(0, 0), a2, voffA);
            PG8_BAR; PG8_WAIT_L(0); PG8_MMA(1, 0, At, B0); PG8_BAR; PG8_SCHED;
            PG8_STAGE(PG8_SB(0, 1), b2 + hstep, voffB);
            PG8_WAIT_V(6); PG8_BAR; PG8_MMA(1, 1, At, B1); PG8_BAR;
            PG8_LDB(B0, 1, 0); PG8_SCHED; PG8_LDA(At, 1, 0); PG8_STAGE(PG8_SA(0, 1), a2 + hstep, voffA);
            PG8_WAIT_L(8); PG8_BAR; PG8_WAIT_L(0); PG8_MMA(0, 0, At, B0); PG8_BAR; PG8_SCHED;
            PG8_LDB(B1, 1, 1); PG8_STAGE(PG8_SB(1, 0), b3, voffB);
            PG8_BAR; PG8_WAIT_L(0); PG8_MMA(0, 1, At, B1); PG8_BAR;
            PG8_LDA(At, 1, 1); PG8_STAGE(PG8_SA(1, 0), a3, voffA);
            PG8_BAR; PG8_WAIT_L(0); PG8_MMA(1, 0, At, B0); PG8_BAR; PG8_SCHED;
            PG8_STAGE(PG8_SB(1, 1), b3 + hstep, voffB);
            PG8_WAIT_V(6); PG8_BAR; PG8_MMA(1, 1, At, B1); PG8_BAR;
            }
        }
        if constexpr (ALIGN_EPI) { if (wr == 0) PG8_BAR; }
        if constexpr (!Epi::AFTER_DRAIN) { E(acc, cur, wr, wc, fr, fq); S.done(cur); }
        if (!has_next) break;
#pragma unroll
        for (int a = 0; a < 2; ++a)
#pragma unroll
            for (int b = 0; b < 2; ++b)
#pragma unroll
                for (int m = 0; m < 4; ++m)
#pragma unroll
                    for (int n = 0; n < 2; ++n) acc[a][b][m][n] = (f32x4){0.f, 0.f, 0.f, 0.f};
        cur = nxt; cA = nA; cB = nB; ++ui;
        if constexpr (ALIGN_EPI) { if (wr == 1) PG8_BAR; }
    }
    PG8_WAIT_V(0);
    if constexpr (!ALIGN_EPI) { if (wr == 0) PG8_BAR; }
    PG8_BAR;
    if constexpr (Epi::AFTER_DRAIN) { E.fused(acc, cur, wr, wc, fr, fq, lds, wid, lane); S.done(cur); }
#undef PG8_SA
#undef PG8_SB
#undef PG8_STAGE
#undef PG8_LDA
#undef PG8_LDB
#undef PG8_MMA
#undef PG8_WAIT_V
#undef PG8_WAIT_L
#undef PG8_BAR
#undef PG8_SCHED
}
}
#define LAS __attribute__((address_space(3)))
typedef unsigned short bf16_t;
typedef short bf16x8 __attribute__((ext_vector_type(8)));
typedef short s16x4 __attribute__((ext_vector_type(4)));
typedef float f32x2 __attribute__((ext_vector_type(2)));
typedef float f32x4 __attribute__((ext_vector_type(4)));
typedef float f32x16 __attribute__((ext_vector_type(16)));
typedef unsigned u32x2 __attribute__((ext_vector_type(2)));
typedef unsigned u32x4 __attribute__((ext_vector_type(4)));

constexpr int NB = 16, SEQ = 4096, DM = 1024, FF = 2816, M = NB * SEQ;
constexpr float EPS = 1e-6f, LOG2E = 1.4426950408889634f;
constexpr float QSCALE = 0.125f * LOG2E;
constexpr size_t MiB = 1u << 20;
constexpr size_t WS_W1IN = 1 * MiB, WS_W1OUT = 12 * MiB, WS_WMIN = 18 * MiB, WS_WMOUT = 26 * MiB, WS_W2IN = 28 * MiB, WS_W2OUT = 39 * MiB;
constexpr size_t WS_LB = 50 * MiB, WS_XB = 52 * MiB, WS_XN2 = 192 * MiB  , WS_PART = 45 * MiB, WS_XN = 64 * MiB, WS_Y = 192 * MiB, WS_BIG = 320 * MiB;
constexpr size_t MIXSZ = (size_t)M * 512;
enum { MB_QA = 0, MB_KA, MB_VA, MB_QR, MB_IR, MB_GF, MB_KF, MB_GB, MB_KB, MB_GR };
constexpr int LDS_BYTES = 147456;
constexpr int CTL_BAR = 3 * 256 * 64;

__device__ __forceinline__ unsigned pkbf(float lo, float hi) { typedef __bf16 b2 __attribute__((ext_vector_type(2))); f32x2 v = {lo, hi}; b2 b = __builtin_convertvector(v, b2); return __builtin_bit_cast(unsigned, b); }
__device__ __forceinline__ unsigned pkh(float lo, float hi) { typedef _Float16 h2 __attribute__((ext_vector_type(2))); h2 v = {(_Float16)lo, (_Float16)hi}; return __builtin_bit_cast(unsigned, v); }
__device__ __forceinline__ float bflo(unsigned u) { return __uint_as_float(u << 16); }
__device__ __forceinline__ float bfhi(unsigned u) { return __uint_as_float(u & 0xffff0000u); }
__device__ __forceinline__ float hlo(unsigned u) { typedef _Float16 h2 __attribute__((ext_vector_type(2))); h2 v = __builtin_bit_cast(h2, u); return (float)v[0]; }
__device__ __forceinline__ float hhi(unsigned u) { typedef _Float16 h2 __attribute__((ext_vector_type(2))); h2 v = __builtin_bit_cast(h2, u); return (float)v[1]; }
__device__ __forceinline__ float wave_sum(float v) {
#pragma unroll
    for (int o = 1; o < 64; o <<= 1) v += __shfl_xor(v, o);
    return v;
}
__device__ __forceinline__ float sigmoidf_(float z) { return __builtin_amdgcn_rcpf(1.0f + __expf(-z)); }
__device__ __forceinline__ float siluf_(float z) { return z * sigmoidf_(z); }
__device__ __forceinline__ int crow(int i, int h) { return (i & 3) + 8 * (i >> 2) + 4 * h; }
#define MFMA32(a, b, c) __builtin_amdgcn_mfma_f32_32x32x16_bf16((a), (b), (c), 0, 0, 0)
typedef short v4i16_t __attribute__((ext_vector_type(4)));
__device__ __forceinline__ s16x4 trrd(LAS const unsigned char* p) { return __builtin_bit_cast(s16x4, __builtin_amdgcn_ds_read_tr16_b64_v4i16((LAS v4i16_t*)p)); }
__device__ __forceinline__ bf16x8 cat8(s16x4 lo, s16x4 hi) { return (bf16x8){lo[0], lo[1], lo[2], lo[3], hi[0], hi[1], hi[2], hi[3]}; }

using pg8::Unit;
__device__ __forceinline__ float row_scale(const float* part2, int row) {
    const f32x4 a = *(const f32x4*)(part2 + (size_t)row * 16), b = *(const f32x4*)(part2 + (size_t)row * 16 + 4), c = *(const f32x4*)(part2 + (size_t)row * 16 + 8), d = *(const f32x4*)(part2 + (size_t)row * 16 + 12);
    const float s = ((a[0] + a[1]) + (a[2] + a[3])) + ((b[0] + b[1]) + (b[2] + b[3])) + ((c[0] + c[1]) + (c[2] + c[3])) + ((d[0] + d[1]) + (d[2] + d[3]));
    return rsqrtf(s * (1.0f / DM) + EPS);
}
struct EpiSwiglu {
    static constexpr bool PERM = true, AFTER_DRAIN = false;
    bf16_t* H; const LAS float* rsl;
    __device__ __forceinline__ void operator()(const f32x4 (&acc)[2][2][4][2], const Unit& u, int wr, int wc, int fr, int fq) const {
        const int row0 = u.pm * 256 + wr * 64 + fr, col0 = u.pn * 128 + wc * 32 + 8 * fq;
        const LAS float* rsp = rsl + ((u.pm >> 3) & 3) * 256 + wr * 64 + fr;
#pragma unroll
        for (int ai = 0; ai < 2; ++ai)
#pragma unroll
            for (int m = 0; m < 4; ++m) {
                bf16_t* rowp = H + (size_t)(row0 + ai * 128 + m * 16) * FF + col0;
                const float rsc = rsp[ai * 128 + m * 16];
                float o[8];
#pragma unroll
                for (int n = 0; n < 2; ++n)
#pragma unroll
                    for (int e = 0; e < 4; ++e) o[4 * n + e] = siluf_(acc[ai][0][m][n][e] * rsc) * (acc[ai][1][m][n][e] * rsc);
                u32x4 w; w.x = pkbf(o[0], o[1]); w.y = pkbf(o[2], o[3]); w.z = pkbf(o[4], o[5]); w.w = pkbf(o[6], o[7]);
                __builtin_nontemporal_store(w, (u32x4*)rowp);
            }
    }
};
template <bool LAST, bool BASEBF> struct EpiResNorm {
    static constexpr bool PERM = true, AFTER_DRAIN = false;
    const void* base; float* out; const LAS float* wpost; float alpha; bf16_t* XNo; float* part2;
    float* xbuf; unsigned* cnt; LAS unsigned char* xl;
    __device__ __forceinline__ void operator()(const f32x4 (&acc)[2][2][4][2], const Unit& u, int wr, int wc, int fr, int fq) const {
        const int lane = fr + 16 * fq, wid = wr * 4 + wc;
        LAS float* P = (LAS float*)xl; LAS float* S = (LAS float*)(xl + 4096);
        const int col0 = u.pn * 256 + wc * 32 + 8 * fq;
        const size_t rob = (size_t)(u.pm * 256 + wr * 64 + fr) * DM + col0;
        static_assert(BASEBF, "the residual stream is bf16");
        u32x4 rb[4][2];
#define ER_LOAD(st_) do { _Pragma("unroll") for (int bj = 0; bj < 2; ++bj) rb[(st_) & 3][bj] = *(const u32x4*)((const bf16_t*)base + rob + (size_t)(((st_) >> 2) * 128 + ((st_) & 3) * 16) * DM + bj * 128); } while (0)
        ER_LOAD(0); ER_LOAD(1); ER_LOAD(2); ER_LOAD(3);
#pragma unroll
        for (int ai = 0; ai < 2; ++ai)
#pragma unroll
            for (int m = 0; m < 4; ++m) {
                float ss = 0.f;
#pragma unroll
                for (int bj = 0; bj < 2; ++bj)
#pragma unroll
                    for (int n = 0; n < 2; ++n) { const f32x4 v = acc[ai][bj][m][n]; ss += (v[0] * v[0] + v[1] * v[1]) + (v[2] * v[2] + v[3] * v[3]); }
                ss += __shfl_xor(ss, 16); ss += __shfl_xor(ss, 32);
                if (fq == 0) P[(ai * 128 + wr * 64 + m * 16 + fr) * 4 + wc] = ss;
            }
        asm volatile("s_waitcnt lgkmcnt(0)" ::: "memory"); __builtin_amdgcn_s_barrier(); asm volatile("" ::: "memory");
        const int row = wid * 32 + (lane & 31);
        if (lane < 32) { const f32x4 pp = *(LAS const f32x4*)(P + row * 4);
            __hip_atomic_store(xbuf + ((size_t)(u.pm * 4 + u.pn) * 256 + row), (pp[0] + pp[1]) + (pp[2] + pp[3]), __ATOMIC_RELAXED, __HIP_MEMORY_SCOPE_AGENT); }
        asm volatile("s_waitcnt vmcnt(0)" ::: "memory");
        if (lane == 0) __hip_atomic_fetch_add(cnt + 64 * u.pm, 1u, __ATOMIC_RELAXED, __HIP_MEMORY_SCOPE_AGENT);
        if (wid == 0) { unsigned spins = 0;
            while ((unsigned)__builtin_amdgcn_readfirstlane((int)__hip_atomic_load(cnt + 64 * u.pm, __ATOMIC_RELAXED, __HIP_MEMORY_SCOPE_AGENT)) < 32u) { __builtin_amdgcn_s_sleep(2); if (++spins > (1u << 18)) break; }
            __builtin_amdgcn_fence(__ATOMIC_ACQUIRE, "agent"); }
        asm volatile("s_waitcnt vmcnt(0) lgkmcnt(0)" ::: "memory"); __builtin_amdgcn_s_barrier(); asm volatile("" ::: "memory");
        if (lane < 32) { const float* sl = xbuf + (size_t)(u.pm * 4) * 256 + row; float s4 = 0.f;
#pragma unroll
            for (int t = 0; t < 4; ++t) s4 += __hip_atomic_load(sl + t * 256, __ATOMIC_RELAXED, __HIP_MEMORY_SCOPE_AGENT);
            S[row] = alpha * rsqrtf(s4 * (1.0f / DM) + EPS); }
        asm volatile("s_waitcnt vmcnt(0) lgkmcnt(0)" ::: "memory"); __builtin_amdgcn_s_barrier(); asm volatile("" ::: "memory");
#pragma unroll
        for (int st = 0; st < 8; ++st) {
            const int ai = st >> 2, m = st & 3;
            const int rl = ai * 128 + wr * 64 + m * 16 + fr; const size_t ro = rob + (size_t)(ai * 128 + m * 16) * DM;
            f32x4 cb[2][2];
#pragma unroll
            for (int bj = 0; bj < 2; ++bj) { const u32x4 q = rb[st & 3][bj];
                cb[bj][0] = (f32x4){bflo(q.x), bfhi(q.x), bflo(q.y), bfhi(q.y)}; cb[bj][1] = (f32x4){bflo(q.z), bfhi(q.z), bflo(q.w), bfhi(q.w)}; }
            if (st < 4) ER_LOAD(st + 4);
            const float r = S[rl]; float ss = 0.f;
            int cw = col0; asm volatile("" : "+v"(cw));
#pragma unroll
            for (int bj = 0; bj < 2; ++bj) {
                const f32x4 w0 = *(const LAS f32x4*)(wpost + cw + bj * 128), w1 = *(const LAS f32x4*)(wpost + cw + bj * 128 + 4);
                const f32x4 h0 = cb[bj][0] + acc[ai][bj][m][0] * r * w0, h1 = cb[bj][1] + acc[ai][bj][m][1] * r * w1;
                if (LAST) { __builtin_nontemporal_store(h0, (f32x4*)(out + ro + bj * 128)); __builtin_nontemporal_store(h1, (f32x4*)(out + ro + bj * 128 + 4)); }
                else {
                    ss += (h0[0] * h0[0] + h0[1] * h0[1]) + (h0[2] * h0[2] + h0[3] * h0[3]) + (h1[0] * h1[0] + h1[1] * h1[1]) + (h1[2] * h1[2] + h1[3] * h1[3]);
                    u32x4 w; w.x = pkbf(h0[0], h0[1]); w.y = pkbf(h0[2], h0[3]); w.z = pkbf(h1[0], h1[1]); w.w = pkbf(h1[2], h1[3]);
                    *(u32x4*)(XNo + ro + bj * 128) = w;
                }
            }
            if (!LAST) { ss += __shfl_xor(ss, 16); ss += __shfl_xor(ss, 32); if (fq == 0) part2[(size_t)(u.pm * 256 + rl) * 16 + u.pn * 4 + wc] = ss; }
        }
#undef ER_LOAD
    }
};
__device__ __forceinline__ void stage_gain(LAS float* wl, const float* w, int tid) { wl[tid] = w[tid]; wl[tid + 512] = w[tid + 512]; __syncthreads(); }
__device__ __forceinline__ void fill_row_scales(LAS float* rsl, const float* part2, int bx, int tid) {
    for (int e = tid; e < 1024; e += 512) { const int g4 = e >> 8, rw = e & 255, pm = 8 * (4 * (bx & 7) + g4) + ((bx >> 3) & 7); rsl[e] = row_scale(part2, pm * 256 + rw); }
    __syncthreads();
}
struct EpiMix {
    static constexpr bool PERM = true, AFTER_DRAIN = false;
    bf16_t* mix; const LAS float* lbl; const LAS float* rsl;
    __device__ __forceinline__ void operator()(const f32x4 (&acc)[2][2][4][2], const Unit& u, int wr, int wc, int fr, int fq) const {
        const int g = u.pn >> 1;
        const int row0 = u.pm * 256 + wr * 64 + fr, col0 = (u.pn & 1) * 256 + wc * 32 + 8 * fq;
        const LAS float* rsp = rsl + ((u.pm >> 3) & 3) * 256 + wr * 64 + fr;
        if (g == 5 || g == 6) {
            const int dir = g - 5;
            bf16_t* Kb = mix + (size_t)(MB_KF + 2 * dir) * MIXSZ;
#pragma unroll
            for (int ai = 0; ai < 2; ++ai)
#pragma unroll
                for (int m = 0; m < 4; ++m) {
                    const size_t ro = (size_t)(row0 + ai * 128 + m * 16) * 512 + col0;
                    const float rsc = rsp[ai * 128 + m * 16];
#pragma unroll
                    for (int bj = 0; bj < 2; ++bj) {
                        float kk[8];
                        const f32x4 lb0 = *(const LAS f32x4*)(lbl + dir * 512 + col0 + bj * 128), lb1 = *(const LAS f32x4*)(lbl + dir * 512 + col0 + bj * 128 + 4);
#pragma unroll
                        for (int e = 0; e < 8; ++e) {
                            const float z = acc[ai][bj][m][e >> 2][e & 3] * rsc, lbv = e < 4 ? lb0[e & 3] : lb1[e & 3];
                            const float ez = __expf(-z), sg = __builtin_amdgcn_rcpf(1.0f + ez), om = 1.0f - lbv;
                            kk[e] = om * (ez * sg);
                        }
                        u32x4 wk;
                        wk.x = pkbf(kk[0], kk[1]); wk.y = pkbf(kk[2], kk[3]); wk.z = pkbf(kk[4], kk[5]); wk.w = pkbf(kk[6], kk[7]);
                        __builtin_nontemporal_store(wk, (u32x4*)(Kb + ro + bj * 128));
                    }
                }
        } else {
            bf16_t* O = mix + (size_t)(g < 5 ? g : MB_GR) * MIXSZ;
            const bool dosilu = (g == 3 || g == 7); const float sc = (g == 0) ? QSCALE : 1.0f;
#pragma unroll
            for (int ai = 0; ai < 2; ++ai)
#pragma unroll
                for (int m = 0; m < 4; ++m) {
                    const size_t ro = (size_t)(row0 + ai * 128 + m * 16) * 512 + col0;
                    const float rsc = rsp[ai * 128 + m * 16];
#pragma unroll
                    for (int bj = 0; bj < 2; ++bj) {
                        float o[8];
                        if (dosilu) { _Pragma("unroll") for (int e = 0; e < 8; ++e) o[e] = siluf_(acc[ai][bj][m][e >> 2][e & 3] * rsc); }
                        else { const float rs2 = rsc * sc; _Pragma("unroll") for (int e = 0; e < 8; ++e) o[e] = acc[ai][bj][m][e >> 2][e & 3] * rs2; }
                        u32x4 w; w.x = pkbf(o[0], o[1]); w.y = pkbf(o[2], o[3]); w.z = pkbf(o[4], o[5]); w.w = pkbf(o[6], o[7]);
                        __builtin_nontemporal_store(w, (u32x4*)(O + ro + bj * 128));
                    }
                }
        }
    }
};

template <int MODE>
__device__ __forceinline__ void transpose_item(const float* W, int K, int N, bf16_t* WT, LAS float* scr, int item, int lane, const float* kw) {
    const int nblk = N / 32, kb = item / nblk, nb = item % nblk, k0 = 64 * kb, n0 = 32 * nb;
    { f32x4 t[8];
#pragma unroll
      for (int i = 0; i < 8; ++i) t[i] = __builtin_nontemporal_load((const f32x4*)(W + (size_t)(k0 + 8 * i + (lane >> 3)) * N + n0 + 4 * (lane & 7)));
#pragma unroll
      for (int i = 0; i < 8; ++i) { LAS float* d = scr + (8 * i + (lane >> 3)) * 33 + 4 * (lane & 7); const float g = kw ? kw[k0 + 8 * i + (lane >> 3)] : 1.0f; d[0] = t[i][0] * g; d[1] = t[i][1] * g; d[2] = t[i][2] * g; d[3] = t[i][3] * g; } }
    asm volatile("s_waitcnt lgkmcnt(0)" ::: "memory");
    int d0 = n0;
    if (MODE == 1) { const int half = N / 2; const int up = n0 >= half ? 1 : 0; const int j = n0 - up * half; d0 = (j / 128) * 256 + up * 128 + (j % 128); }
    const int c = lane & 7;
#pragma unroll
    for (int j = 0; j < 4; ++j) { const int n = (lane >> 3) + 8 * j; const LAS float* s = scr + (8 * c) * 33 + n;
        u32x4 o; o.x = pkbf(s[0 * 33], s[1 * 33]); o.y = pkbf(s[2 * 33], s[3 * 33]); o.z = pkbf(s[4 * 33], s[5 * 33]); o.w = pkbf(s[6 * 33], s[7 * 33]);
        *(u32x4*)(WT + (size_t)(d0 + n) * K + k0 + 8 * c) = o; }
    asm volatile("s_waitcnt lgkmcnt(0)" ::: "memory");
}

template <bool HASY, bool WRITEH, bool WRITEXN>
__device__ __forceinline__ void norm_rows(int gw, int ngw, int lane, const float* base, const bf16_t* Y, const float* part, const float* wpost, float alpha,
                                          float* hout, const float* wpre, bf16_t* XN) {
    constexpr int RB = 4;
    for (int m0 = gw * RB; m0 < M; m0 += ngw * RB) {
        f32x4 v[RB][4]; u32x2 y[RB][4]; float ps[RB];
#pragma unroll
        for (int rr = 0; rr < RB; ++rr) {
            const size_t m = (size_t)(m0 + rr);
#pragma unroll
            for (int j = 0; j < 4; ++j) v[rr][j] = __builtin_nontemporal_load(((const f32x4*)(base + m * DM)) + lane + 64 * j);
            if (HASY) {
#pragma unroll
                for (int j = 0; j < 4; ++j) y[rr][j] = __builtin_nontemporal_load(((const u32x2*)(Y + m * DM)) + lane + 64 * j);
                ps[rr] = part[m * 16 + (lane & 15)];
            }
        }
#pragma unroll
        for (int rr = 0; rr < RB; ++rr) {
            const size_t m = (size_t)(m0 + rr);
            if (HASY) {
                float p = ps[rr];
                p += __shfl_xor(p, 1); p += __shfl_xor(p, 2); p += __shfl_xor(p, 4); p += __shfl_xor(p, 8);
                const float r = alpha * rsqrtf(p * (1.0f / DM) + EPS);
#pragma unroll
                for (int j = 0; j < 4; ++j) {
                    const f32x4 w = ((const f32x4*)wpost)[lane + 64 * j];
                    v[rr][j][0] += bflo(y[rr][j].x) * r * w[0]; v[rr][j][1] += bfhi(y[rr][j].x) * r * w[1]; v[rr][j][2] += bflo(y[rr][j].y) * r * w[2]; v[rr][j][3] += bfhi(y[rr][j].y) * r * w[3];
                }
            }
            if (WRITEH) {
#pragma unroll
                for (int j = 0; j < 4; ++j) ((f32x4*)(hout + m * DM))[lane + 64 * j] = v[rr][j];
            }
            if (WRITEXN) {
                float s2 = 0.f;
#pragma unroll
                for (int j = 0; j < 4; ++j) s2 += (v[rr][j][0] * v[rr][j][0] + v[rr][j][1] * v[rr][j][1]) + (v[rr][j][2] * v[rr][j][2] + v[rr][j][3] * v[rr][j][3]);
                s2 = wave_sum(s2);
                if (lane < 16) hout[m * 16 + lane] = (lane == 0) ? s2 : 0.f;
#pragma unroll
                for (int j = 0; j < 4; ++j) {
                    u32x2 o; o.x = pkbf(v[rr][j][0], v[rr][j][1]); o.y = pkbf(v[rr][j][2], v[rr][j][3]);
                    ((u32x2*)(XN + m * DM))[lane + 64 * j] = o;
                }
            }
        }
    }
}
constexpr int AT_QP = 144, AT_KB = 16384, AT_VB = 16384, AT_V0 = 3 * AT_KB, AT_Q = AT_V0 + 2 * AT_VB, AT_TAB = AT_Q + 8 * 32 * AT_QP;
static_assert(AT_TAB + 4 * 324 * 4 <= 131072 && AT_Q >= 65536, "attention lds");
__device__ __forceinline__ void glds16(unsigned voff, const void* gbase, unsigned lds_dst) { unsigned keep;
    asm volatile("s_mov_b32 %0, m0\n\ts_mov_b32 m0, %2\n\ts_nop 0\n\tglobal_load_lds_dwordx4 %1, %3\n\ts_mov_b32 m0, %0" : "=&s"(keep) : "v"(voff), "s"(lds_dst), "s"(gbase) : "memory"); }
#define AT_WAIT_BAR() asm volatile("s_waitcnt vmcnt(0) lgkmcnt(0)\n\ts_barrier" ::: "memory")
__device__ __forceinline__ float xhalf_max(float m) { auto rr = __builtin_amdgcn_permlane32_swap(__float_as_uint(m), __float_as_uint(m), false, false); return fmaxf(__uint_as_float(rr[0]), __uint_as_float(rr[1])); }
__device__ __forceinline__ float xhalf_sum(float m) { auto rr = __builtin_amdgcn_permlane32_swap(__float_as_uint(m), __float_as_uint(m), false, false); return __uint_as_float(rr[0]) + __uint_as_float(rr[1]); }
__device__ __forceinline__ void attn_phase(LAS unsigned char* lds, const bf16_t* QA, const bf16_t* KA, const bf16_t* VA, bf16_t* CAT, const bf16_t* OF, const bf16_t* OB, const bf16_t* GR, const float* rnorm,
                                           const float* rel_bias, const float* lq1, const float* lk1, const float* lq2, const float* lk2, const float* anorm, int vcu) {
    int tid = threadIdx.x; asm volatile("" : "+v"(tid));
    const int lane = tid & 63, wid = __builtin_amdgcn_readfirstlane(tid >> 6), r = lane & 31, h = lane >> 5;
    LAS float* tab = (LAS float*)(lds + AT_TAB);
    const float lam = __expf(wave_sum(lq1[lane] * lk1[lane])) - __expf(wave_sum(lq2[lane] * lk2[lane])) + 0.2f;
    for (int e = tid; e < 4 * 321; e += 512) {
        const int hd = e / 321, idx = e % 321, rel = idx - 160, n = rel < 0 ? -rel : rel, side = rel > 0 ? 16 : 0;
        int bk = n;
        if (n >= 8) { const float lf = logf((float)n / 8.0f) / 2.772588722239781f * 8.0f; bk = 8 + (int)lf; bk = bk < 15 ? bk : 15; }
        tab[hd * 324 + idx] = rel_bias[(side + bk) * 4 + hd] * LOG2E;
    }
    __syncthreads();
    const int c = wid >> 2, qw = wid & 3;
    const unsigned lds0 = (unsigned)(uintptr_t)lds;
    const unsigned dmaoff = (unsigned)wid * 1024u;
    unsigned kvo0, kvo1, vvo0, vvo1;
    { const int drow0 = 4 * wid + (lane >> 4), drow1 = drow0 + 32, dsl = lane & 15;
      kvo0 = (unsigned)(drow0 * 512 + (dsl ^ (drow0 & 15)) * 8) * 2u; kvo1 = (unsigned)(drow1 * 512 + (dsl ^ (drow1 & 15)) * 8) * 2u;
      vvo0 = (unsigned)(drow0 * 512 + (dsl ^ (4 * (drow0 & 3))) * 8) * 2u; vvo1 = (unsigned)(drow1 * 512 + (dsl ^ (4 * (drow1 & 3))) * 8) * 2u; }
    int kro[4], vro[4];
    { const int q_ = (lane & 15) >> 2, p_ = lane & 3, g16 = (lane >> 4) & 1;
#pragma unroll
      for (int d0 = 0; d0 < 4; ++d0) kro[d0] = r * 256 + ((c * 8 + 2 * d0 + h) ^ (r & 15)) * 16;
#pragma unroll
      for (int k = 0; k < 4; ++k) vro[k] = (4 * h + q_) * 256 + (4 * (k ^ q_) + 2 * g16 + (p_ >> 1)) * 16 + 8 * (p_ & 1); }
    for (int it = 0; it < 8; ++it) {
        const int unit = it * 256 + vcu, bh = unit >> 5, qb = unit & 31, b = bh >> 2, hd = bh & 3;
        const size_t tok0 = (size_t)b * SEQ;
        const int q0 = qb * 128 + qw * 32;
        bf16x8 qf[4];
        { const bf16_t* qp = QA + (tok0 + q0 + r) * 512 + hd * 128 + c * 64 + 8 * h;
#pragma unroll
          for (int d0 = 0; d0 < 4; ++d0) qf[d0] = *(const bf16x8*)(qp + 16 * d0); }
        f32x16 o[4], negc;
#pragma unroll
        for (int i = 0; i < 16; ++i) { o[0][i] = 0.f; o[1][i] = 0.f; o[2][i] = 0.f; o[3][i] = 0.f; negc[i] = 0.f; }
        float lsum = 0.f;
        const bf16_t* kgb = KA + tok0 * 512 + hd * 128; const bf16_t* vgb = VA + tok0 * 512 + hd * 128;
#define AT_DMAK(t_) do { const bf16_t* gb_ = kgb + (size_t)(t_) * 64 * 512; const unsigned d_ = (unsigned)__builtin_amdgcn_readfirstlane(lds0 + ((t_) % 3) * AT_KB + dmaoff); glds16(kvo0, gb_, d_); glds16(kvo1, gb_, d_ + 8192u); } while (0)
#define AT_DMAV(t_) do { const bf16_t* gb_ = vgb + (size_t)(t_) * 64 * 512; const unsigned d_ = (unsigned)__builtin_amdgcn_readfirstlane(lds0 + AT_V0 + ((t_) & 1) * AT_VB + dmaoff); glds16(vvo0, gb_, d_); glds16(vvo1, gb_, d_ + 8192u); } while (0)
        AT_DMAK(0); AT_DMAV(0); AT_DMAK(1);
        AT_WAIT_BAR();
        const float bleft = tab[hd * 324 + 0], bright = tab[hd * 324 + 320];
#define AT_CLS(u_) (((u_) * 32 + 31 - q0 <= -91) ? 0 : (((u_) * 32 - (q0 + 31) >= 91) ? 2 : 1))
        int ccls = 1;
#define AT_SETCLS(u_) do { const int nc_ = AT_CLS(u_); if (nc_ != ccls) { const float d_ = (nc_ == 0 ? bleft : (nc_ == 2 ? bright : 0.f)) - (ccls == 0 ? bleft : (ccls == 2 ? bright : 0.f)); \
            _Pragma("unroll") for (int i = 0; i < 16; ++i) negc[i] += d_; ccls = nc_; } } while (0)
#define AT_QK(P, u_) do { LAS const unsigned char* kp_ = lds + ((((u_) >> 1) % 3) * AT_KB + ((u_) & 1) * 8192); \
            { const bf16x8 ka = *(LAS const bf16x8*)(kp_ + kro[0]); P = MFMA32(ka, qf[0], negc); } \
            _Pragma("unroll") for (int d0 = 1; d0 < 4; ++d0) { const bf16x8 ka = *(LAS const bf16x8*)(kp_ + kro[d0]); P = MFMA32(ka, qf[d0], P); } } while (0)
#define AT_HSTEP(A, B, t_, HF) do { const int u_ = 2 * (t_) + (HF); \
            if ((HF) == 0) { if ((t_) + 2 < 64) AT_DMAK((t_) + 2); if ((t_) + 1 < 64) AT_DMAV((t_) + 1); } \
            AT_SETCLS(u_ + 1);                                 \
            if (AT_CLS(u_) == 1) { int rb = u_ * 32 - (q0 + r); asm volatile("" : "+v"(rb));   \
                const LAS float* tp_ = tab + hd * 324 + 160 + rb + 4 * h; \
                _Pragma("unroll") for (int i = 0; i < 16; ++i) A[i] += tp_[(i & 3) + 8 * (i >> 2)]; } \
              \
              \
              \
              \
            AT_QK(B, u_ + 1); \
            f32x16 E; float ls = 0.f; \
            _Pragma("unroll") for (int i = 0; i < 16; ++i) { E[i] = __builtin_amdgcn_exp2f(A[i]); ls += E[i]; } \
            if (u_ == 0 || __any(!(ls <= 256.0f))) { \
                float mx = fmaxf(fmaxf(A[0], A[1]), A[2]); \
                _Pragma("unroll") for (int i = 3; i < 15; i += 2) mx = fmaxf(fmaxf(mx, A[i]), A[i + 1]); \
                mx = xhalf_max(fmaxf(mx, A[15])); \
                const float dl = (u_ == 0) ? mx : fmaxf(mx, 0.f); const float f = __builtin_amdgcn_exp2f(-dl); ls = 0.f; \
                _Pragma("unroll") for (int i = 0; i < 16; ++i) { E[i] = __builtin_amdgcn_exp2f(A[i] - dl); ls += E[i]; B[i] -= dl; negc[i] -= dl; o[0][i] *= f; o[1][i] *= f; o[2][i] *= f; o[3][i] *= f; } \
                lsum *= f; } \
            lsum += ls; \
            { LAS const unsigned char* vb = lds + AT_V0 + ((t_) & 1) * AT_VB + (HF) * 8192; \
              _Pragma("unroll") for (int s = 0; s < 2; ++s) { u32x4 w; \
                  if (s == 0) { w.x = pkbf(E[0], E[1]); w.y = pkbf(E[2], E[3]); w.z = pkbf(E[4], E[5]); w.w = pkbf(E[6], E[7]); } \
                  if (s == 1) { w.x = pkbf(E[8], E[9]); w.y = pkbf(E[10], E[11]); w.z = pkbf(E[12], E[13]); w.w = pkbf(E[14], E[15]); } \
                  const bf16x8 pf = __builtin_bit_cast(bf16x8, w); \
                  _Pragma("unroll") for (int k = 0; k < 4; ++k) { \
                      const s16x4 lo = trrd(vb + vro[k] + (16 * s) * 256), hi = trrd(vb + vro[k] + (16 * s + 8) * 256); \
                      o[k] = MFMA32(cat8(lo, hi), pf, o[k]); } } } \
            if ((HF) == 1) AT_WAIT_BAR(); } while (0)
        f32x16 sA, sB;
#pragma unroll
        for (int i = 0; i < 16; ++i) sB[i] = 0.f;
        AT_SETCLS(0); AT_QK(sA, 0);
        for (int t = 0; t < 64; ++t) { AT_HSTEP(sA, sB, t, 0); AT_HSTEP(sB, sA, t, 1); }
#undef AT_DMAK
#undef AT_DMAV
#undef AT_CLS
#undef AT_SETCLS
#undef AT_QK
#undef AT_HSTEP
        lsum = xhalf_sum(lsum);
        const float inv = __builtin_amdgcn_rcpf(lsum);
        LAS float* X = (LAS float*)lds;
        if (c == 1) { const float f = lam * inv;
#pragma unroll
            for (int k = 0; k < 4; ++k)
#pragma unroll
                for (int i = 0; i < 16; ++i) X[((qw * 4 + k) * 16 + i) * 64 + lane] = o[k][i] * f; }
        __syncthreads();
        if (c == 0) {
            float ss = 0.f;
#pragma unroll
            for (int k = 0; k < 4; ++k)
#pragma unroll
                for (int i = 0; i < 16; ++i) { const float v = o[k][i] * inv - X[((qw * 4 + k) * 16 + i) * 64 + lane]; o[k][i] = v; ss += v * v; }
            ss = xhalf_sum(ss);
            const float rr = rsqrtf(ss * (1.0f / 128.0f) + EPS) * 0.8f;
            bf16_t* op = CAT + (tok0 + q0 + r) * DM + hd * 128;
#pragma unroll
            for (int k = 0; k < 4; ++k)
#pragma unroll
                for (int i4 = 0; i4 < 4; ++i4) { const int d = 32 * k + 8 * i4 + 4 * h; const f32x4 w = *(const f32x4*)(anorm + d);
                    u32x2 ov; ov.x = pkbf(o[k][4 * i4] * rr * w[0], o[k][4 * i4 + 1] * rr * w[1]); ov.y = pkbf(o[k][4 * i4 + 2] * rr * w[2], o[k][4 * i4 + 3] * rr * w[3]);
                    *(u32x2*)(op + d) = ov; }
        }
        { const int c8 = (lane & 15) * 8; const f32x4 w0 = *(const f32x4*)(rnorm + c8), w1 = *(const f32x4*)(rnorm + c8 + 4);
          u32x4 a[4], bq[4], g[4];
#pragma unroll
          for (int i4 = 0; i4 < 4; ++i4) { const size_t ro = (tok0 + qb * 128 + 16 * wid + 4 * i4 + (lane >> 4)) * 512 + hd * 128 + c8;
              a[i4] = __builtin_nontemporal_load((const u32x4*)(OF + ro)); bq[i4] = __builtin_nontemporal_load((const u32x4*)(OB + ro)); g[i4] = __builtin_nontemporal_load((const u32x4*)(GR + ro)); }
#pragma unroll
          for (int i4 = 0; i4 < 4; ++i4) {
              float v[8];
              v[0] = bflo(a[i4].x) + bflo(bq[i4].x); v[1] = bfhi(a[i4].x) + bfhi(bq[i4].x); v[2] = bflo(a[i4].y) + bflo(bq[i4].y); v[3] = bfhi(a[i4].y) + bfhi(bq[i4].y);
              v[4] = bflo(a[i4].z) + bflo(bq[i4].z); v[5] = bfhi(a[i4].z) + bfhi(bq[i4].z); v[6] = bflo(a[i4].w) + bflo(bq[i4].w); v[7] = bfhi(a[i4].w) + bfhi(bq[i4].w);
              float ss = 0.f;
#pragma unroll
              for (int e = 0; e < 8; ++e) ss += v[e] * v[e];
              ss += __shfl_xor(ss, 1); ss += __shfl_xor(ss, 2); ss += __shfl_xor(ss, 4); ss += __shfl_xor(ss, 8);
              const float rq = rsqrtf(ss * (1.0f / 128.0f) + EPS);
              u32x4 ov;
              ov.x = pkbf(v[0] * rq * w0[0] * bflo(g[i4].x), v[1] * rq * w0[1] * bfhi(g[i4].x)); ov.y = pkbf(v[2] * rq * w0[2] * bflo(g[i4].y), v[3] * rq * w0[3] * bfhi(g[i4].y));
              ov.z = pkbf(v[4] * rq * w1[0] * bflo(g[i4].z), v[5] * rq * w1[1] * bfhi(g[i4].z)); ov.w = pkbf(v[6] * rq * w1[2] * bflo(g[i4].w), v[7] * rq * w1[3] * bfhi(g[i4].w));
              *(u32x4*)(CAT + (tok0 + qb * 128 + 16 * wid + 4 * i4 + (lane >> 4)) * DM + 512 + hd * 128 + c8) = ov;
          } }
        __syncthreads();
    }
}

constexpr int HG_P = 272, HG_KDP = 320, HG_VP = 192, HG_ASP = 144;
constexpr int HG_QI = 0, HG_KI = 64 * HG_P, HG_QG = 2 * 64 * HG_P, HG_KD = 3 * 64 * HG_P, HG_V = HG_KD + 64 * HG_KDP, HG_AS = HG_V + 64 * HG_VP, HG_ST = HG_AS + 64 * HG_ASP,
              HG_EGL = HG_ST + 64 * HG_P, HG_SEG = HG_EGL + 512, HG_END = HG_SEG + 8 * 128 * 4;
static_assert(HG_END <= 131072 && 131072 + 12288 + 4096 <= LDS_BYTES, "hgrn lds / epilogue tables");
__device__ __forceinline__ void hgrn_phase(LAS unsigned char* lds, const bf16_t* mix, bf16_t* OFB, int item) {
    int tid = threadIdx.x; asm volatile("" : "+v"(tid));
    const int lane = tid & 63, wid = __builtin_amdgcn_readfirstlane(tid >> 6), r = lane & 31, h = lane >> 5;
    const int dvh = item & 1, dir = (item >> 1) & 1, hh = (item >> 2) & 3, b = item >> 4;
    const bf16_t* QR = mix + (size_t)MB_QR * MIXSZ; const bf16_t* IR = mix + (size_t)MB_IR * MIXSZ;
    const bf16_t* KK = mix + (size_t)(MB_KF + 2 * dir) * MIXSZ;
    bf16_t* O = OFB + (size_t)dir * MIXSZ;
    const size_t tok0 = (size_t)b * SEQ;
    for (int e = tid; e < 64 * HG_P / 4; e += 512) ((LAS unsigned*)(lds + HG_ST))[e] = 0u;
    f32x16 sacc;
#pragma unroll
    for (int i = 0; i < 16; ++i) sacc[i] = 0.f;
    const int tv = tid >> 3, cv = tid & 7;
    const int trr = 8 * h + ((lane & 15) >> 2), trc = ((lane >> 4) & 1) * 16 + (lane & 3) * 4;
    unsigned cq[8], ck[8]; u32x4 cvv;
#define HG_BAR() asm volatile("s_waitcnt lgkmcnt(0)\n\ts_barrier" ::: "memory")
#define HG_TOK(c_, t_) (dir ? (SEQ - 1 - ((c_) * 64 + (t_))) : ((c_) * 64 + (t_)))
#define HG_LOAD(c_, q_, k_, v_) do { _Pragma("unroll") for (int j = 0; j < 8; ++j) { const size_t off = (tok0 + HG_TOK(c_, 8 * wid + j)) * 512 + hh * 128 + 2 * lane; \
        q_[j] = *(const unsigned*)(QR + off); k_[j] = *(const unsigned*)(KK + off); } \
        v_ = *(const u32x4*)(IR + (tok0 + HG_TOK(c_, tv)) * 512 + hh * 128 + dvh * 64 + cv * 8); } while (0)
    HG_LOAD(0, cq, ck, cvv);
    __syncthreads();
    for (int c = 0; c < 64; ++c) {
        float c0[8], c1[8];
        { float a0 = 1.f, a1 = 1.f;
#pragma unroll
          for (int j = 0; j < 8; ++j) { a0 *= 1.0f - bflo(ck[j]); a1 *= 1.0f - bfhi(ck[j]); c0[j] = a0; c1[j] = a1; } }
        *(LAS f32x2*)(lds + HG_SEG + (wid * 128 + 2 * lane) * 4) = (f32x2){c0[7], c1[7]};
        unsigned nq[8], nk[8]; u32x4 nv;
        { const int cn = (c + 1 < 64) ? c + 1 : 63; HG_LOAD(cn, nq, nk, nv); }
        HG_BAR();
        float pre0 = 1.f, pre1 = 1.f, mid0 = 1.f, mid1 = 1.f, last0 = 1.f, last1 = 1.f;
#pragma unroll
        for (int s = 0; s < 8; ++s) { const f32x2 tt = *(LAS const f32x2*)(lds + HG_SEG + (s * 128 + 2 * lane) * 4);
            pre0 *= (s < wid) ? tt[0] : 1.f; pre1 *= (s < wid) ? tt[1] : 1.f; if (s < 4) { mid0 *= tt[0]; mid1 *= tt[1]; } last0 *= tt[0]; last1 *= tt[1]; }
        const float rm0 = __builtin_amdgcn_rcpf(mid0), rm1 = __builtin_amdgcn_rcpf(mid1);
        const float eM0 = mid0, eM1 = mid1, eL0 = last0 * rm0, eL1 = last1 * rm1, pr0 = pre0 * rm0, pr1 = pre1 * rm1;
#pragma unroll
        for (int j = 0; j < 8; ++j) {
            const float e10 = pr0 * c0[j], e11 = pr1 * c1[j];
            const float e20 = __builtin_amdgcn_rcpf(e10), e21 = __builtin_amdgcn_rcpf(e11);
            const float qi0 = bflo(cq[j]) * e10, qi1 = bfhi(cq[j]) * e11, ki0 = bflo(ck[j]) * e20, ki1 = bfhi(ck[j]) * e21;
            const int ro = (8 * wid + j), co = 4 * lane;
            *(LAS unsigned*)(lds + HG_QI + ro * HG_P + co) = pkbf(qi0, qi1);
            *(LAS unsigned*)(lds + HG_KI + ro * HG_P + co) = pkbf(ki0, ki1);
            *(LAS unsigned*)(lds + HG_QG + ro * HG_P + co) = pkbf(qi0 * eM0, qi1 * eM1);
            *(LAS unsigned*)(lds + HG_KD + ro * HG_KDP + co) = pkbf(ki0 * eL0, ki1 * eL1);
        }
        *(LAS u32x4*)(lds + HG_V + tv * HG_VP + cv * 16) = cvv;
        if (wid == 0) *(LAS f32x2*)(lds + HG_EGL + 8 * lane) = (f32x2){last0, last1};
        HG_BAR();
        f32x16 oacc;
#pragma unroll
        for (int i = 0; i < 16; ++i) oacc[i] = 0.f;
        const int tb = (wid & 3) >> 1, xb = wid & 1;
        if (wid < 4) {
            if (xb <= tb) {
                f32x16 a;
#pragma unroll
                for (int i = 0; i < 16; ++i) a[i] = 0.f;
#pragma unroll
                for (int kh = 0; kh < 2; ++kh) { bf16x8 A[4], B[4];
#pragma unroll
                    for (int ks = 0; ks < 4; ++ks) { A[ks] = *(LAS const bf16x8*)(lds + HG_QI + (32 * tb + r) * HG_P + (16 * (4 * kh + ks) + 8 * h) * 2);
                        B[ks] = *(LAS const bf16x8*)(lds + HG_KI + (32 * xb + r) * HG_P + (16 * (4 * kh + ks) + 8 * h) * 2); }
#pragma unroll
                    for (int ks = 0; ks < 4; ++ks) a = MFMA32(A[ks], B[ks], a);
                }
#pragma unroll
                for (int i = 0; i < 16; ++i) { const int t = 32 * tb + crow(i, h), s = 32 * xb + r; const float v = (s <= t) ? a[i] : 0.f;
                    *(LAS bf16_t*)(lds + HG_AS + t * HG_ASP + s * 2) = (bf16_t)(pkbf(v, v) & 0xffffu); }
            }
        } else {
#pragma unroll
            for (int kh = 0; kh < 2; ++kh) { bf16x8 A[4], B[4];
#pragma unroll
                for (int ks = 0; ks < 4; ++ks) { A[ks] = *(LAS const bf16x8*)(lds + HG_QG + (32 * tb + r) * HG_P + (16 * (4 * kh + ks) + 8 * h) * 2);
                    B[ks] = *(LAS const bf16x8*)(lds + HG_ST + (32 * xb + r) * HG_P + (16 * (4 * kh + ks) + 8 * h) * 2); }
#pragma unroll
                for (int ks = 0; ks < 4; ++ks) oacc = MFMA32(A[ks], B[ks], oacc);
            }
        }
        HG_BAR();
        if (wid >= 4) {
            const int nks = 2 * (tb + 1);
            for (int ks = 0; ks < nks; ++ks) {
                const bf16x8 A = *(LAS const bf16x8*)(lds + HG_AS + (32 * tb + r) * HG_ASP + (16 * ks + 8 * h) * 2);
                LAS const unsigned char* vp = lds + HG_V + (16 * ks + trr) * HG_VP + (32 * xb + trc) * 2;
                const s16x4 lo = trrd(vp), hi = trrd(vp + 4 * HG_VP);
                oacc = MFMA32(A, cat8(lo, hi), oacc);
            }
#pragma unroll
            for (int i = 0; i < 16; ++i) { const int t = 32 * tb + crow(i, h);
                O[(tok0 + HG_TOK(c, t)) * 512 + hh * 128 + dvh * 64 + 32 * xb + r] = (bf16_t)(pkbf(oacc[i], oacc[i]) & 0xffffu); }
        }
        { const int kb = wid >> 1, vb = wid & 1;
#pragma unroll
          for (int i4 = 0; i4 < 4; ++i4) { const f32x4 eg = *(LAS const f32x4*)(lds + HG_EGL + (32 * kb + 8 * i4 + 4 * h) * 4);
              sacc[4 * i4] *= eg[0]; sacc[4 * i4 + 1] *= eg[1]; sacc[4 * i4 + 2] *= eg[2]; sacc[4 * i4 + 3] *= eg[3]; }
          { bf16x8 Af[4], Bf[4];
#pragma unroll
            for (int ks = 0; ks < 4; ++ks) {
                LAS const unsigned char* ap = lds + HG_KD + (16 * ks + trr) * HG_KDP + (32 * kb + trc) * 2;
                LAS const unsigned char* bp = lds + HG_V + (16 * ks + trr) * HG_VP + (32 * vb + trc) * 2;
                Af[ks] = cat8(trrd(ap), trrd(ap + 4 * HG_KDP)); Bf[ks] = cat8(trrd(bp), trrd(bp + 4 * HG_VP)); }
#pragma unroll
            for (int ks = 0; ks < 4; ++ks) sacc = MFMA32(Af[ks], Bf[ks], sacc); }
#pragma unroll
          for (int i4 = 0; i4 < 4; ++i4) { u32x2 w; w.x = pkbf(sacc[4 * i4], sacc[4 * i4 + 1]); w.y = pkbf(sacc[4 * i4 + 2], sacc[4 * i4 + 3]);
              *(LAS u32x2*)(lds + HG_ST + (32 * vb + r) * HG_P + (32 * kb + 8 * i4 + 4 * h) * 2) = w; } }
#pragma unroll
        for (int j = 0; j < 8; ++j) { cq[j] = nq[j]; ck[j] = nk[j]; }
        cvv = nv;
    }
    __syncthreads();
#undef HG_BAR
#undef HG_TOK
#undef HG_LOAD
}

#define XB_TMO      128
#define XB_XCNT(j)  (256  + 64 * (j))
#define XB_XSUB(j)  (1280 + 64 * (j))
#define XB_XGEN(j)  (2304 + 64 * (j))
#define XB_TOP      3328
#define XB_TOPGEN   3392
#define XCD_BAR_WORDS 3456
#define XB_SPIN_CAP (1u << 18)

__device__ __forceinline__ unsigned xb_ld(unsigned* p)              { return __hip_atomic_load(p, __ATOMIC_RELAXED, __HIP_MEMORY_SCOPE_AGENT); }
__device__ __forceinline__ unsigned xb_add(unsigned* p, unsigned v) { return __hip_atomic_fetch_add(p, v, __ATOMIC_RELAXED, __HIP_MEMORY_SCOPE_AGENT); }
__device__ __forceinline__ unsigned xb_xcc_id() { return (unsigned)__builtin_amdgcn_s_getreg((3 << 11) | 20) & 0xFu; }
#define XB_SPIN(cond, bar) do { unsigned _sp = 0; while (cond) { __builtin_amdgcn_s_sleep(1); \
    if ((++_sp & 255u) == 0u) { if (xb_ld(&(bar)[XB_TMO])) break; if (_sp > XB_SPIN_CAP) { atomicAdd(&(bar)[XB_TMO], 1u); break; } } } } while (0)

struct XcdBarrier {
    unsigned* bar; unsigned x;
    volatile LAS unsigned* st;
};

__device__ __forceinline__ XcdBarrier xcd_barrier_post(unsigned* bar, volatile LAS unsigned* st) {
    XcdBarrier b; b.bar = bar; b.x = xb_xcc_id(); b.st = st;
    if (threadIdx.x == 0) (void)xb_add(&bar[XB_XCNT(b.x)], 1u);
    return b;
}
__device__ __forceinline__ void xcd_barrier_complete(unsigned* bar, unsigned x, unsigned& nloc, unsigned& nx) {
    const unsigned G = gridDim.x * gridDim.y * gridDim.z;
    unsigned sum, cnt, mine, sp = 0u;
    for (;;) {
        sum = 0u; cnt = 0u; mine = 0u;
#pragma unroll
        for (unsigned j = 0; j < 16; ++j) { const unsigned c = xb_ld(&bar[XB_XCNT(j)]); sum += c; cnt += (c > 0u) ? 1u : 0u; mine = (j == x) ? c : mine; }
        if (sum == G) break;
        __builtin_amdgcn_s_sleep(1);
        if ((++sp & 255u) == 0u) { if (xb_ld(&bar[XB_TMO])) break; if (sp > XB_SPIN_CAP) { atomicAdd(&bar[XB_TMO], 1u); break; } }
    }
    nloc = mine > 0u ? mine : 1u; nx = cnt > 0u ? cnt : 1u;
}

__device__ __forceinline__ void xcd_barrier(const XcdBarrier& b) {
    asm volatile("s_waitcnt vmcnt(0)" ::: "memory");
    __syncthreads();
    if (threadIdx.x == 0) {
        unsigned* bar = b.bar;
        __builtin_amdgcn_s_waitcnt(0);
        unsigned nloc = b.st[0], nx = b.st[1];
        if (nloc == 0u) { xcd_barrier_complete(bar, b.x, nloc, nx); b.st[0] = nloc; b.st[1] = nx; }
        const unsigned old = xb_add(&bar[XB_XSUB(b.x)], 1u);
        const unsigned gen = old / nloc;
        if (old + 1u == (gen + 1u) * nloc) {
            __builtin_amdgcn_fence(__ATOMIC_RELEASE, "agent");
            asm volatile("s_waitcnt vmcnt(0)" ::: "memory");
            const unsigned og = xb_add(&bar[XB_TOP], 1u);
            const unsigned tg = og / nx;
            if (og + 1u == (tg + 1u) * nx) xb_add(&bar[XB_TOPGEN], 1u);
            else XB_SPIN(xb_ld(&bar[XB_TOPGEN]) == tg, bar);
            __builtin_amdgcn_fence(__ATOMIC_ACQUIRE, "agent");
            xb_add(&bar[XB_XGEN(b.x)], 1u);
            asm volatile("s_waitcnt vmcnt(0)" ::: "memory");
        } else {
            XB_SPIN(xb_ld(&bar[XB_XGEN(b.x)]) == gen, bar);
            __builtin_amdgcn_fence(__ATOMIC_ACQUIRE, "agent");
            asm volatile("s_waitcnt vmcnt(0)" ::: "memory");
        }
    }
    __syncthreads();
}

struct Params { const float* in[21]; float* out; unsigned char* ws; };
template <int LO, int HI>
__global__ void __launch_bounds__(512, 2) mega(Params p) {
    extern __shared__ __attribute__((aligned(16))) unsigned char lds_raw[];
    LAS unsigned char* lds = (LAS unsigned char*)lds_raw;
    const int tid = threadIdx.x, lane = tid & 63, wid = __builtin_amdgcn_readfirstlane(tid >> 6);
    const int G = gridDim.x, bx = blockIdx.x;
    const int vcu = (G % 8 == 0) ? (bx % 8) * (G / 8) + bx / 8 : bx;
    const int gw = vcu * 8 + wid, ngw = G * 8;
    unsigned char* ws = p.ws;
    bf16_t* W1in = (bf16_t*)(ws + WS_W1IN); bf16_t* W1out = (bf16_t*)(ws + WS_W1OUT); bf16_t* Wmin = (bf16_t*)(ws + WS_WMIN); bf16_t* Wmout = (bf16_t*)(ws + WS_WMOUT);
    bf16_t* W2in = (bf16_t*)(ws + WS_W2IN); bf16_t* W2out = (bf16_t*)(ws + WS_W2OUT);
    float* part = (float*)(ws + WS_PART); bf16_t* XN = (bf16_t*)(ws + WS_XN); bf16_t* Y = (bf16_t*)(ws + WS_Y); bf16_t* BIG = (bf16_t*)(ws + WS_BIG);
    const float* x = p.in[0]; float* out = p.out;

#define IN(k) (LO <= (k) && (k) < HI)
    volatile LAS unsigned* bst = (volatile LAS unsigned*)(lds + 131072 + 6144);
    if (tid < 2) bst[tid] = 0u;
    __syncthreads();
    XcdBarrier xbar; xbar.bar = (unsigned*)ws + CTL_BAR; xbar.x = 0; xbar.st = bst;
#define GSYNC(k) do { if constexpr (IN(k) && IN((k) + 1)) xcd_barrier(xbar); } while (0)
    unsigned* ctl = (unsigned*)ws;
    float* xb = (float*)(ws + WS_XB);
    LAS unsigned char* xl = lds + 131072;
    for (int e = bx * 512 + tid; e < CTL_BAR + XCD_BAR_WORDS; e += G * 512) ctl[e] = 0u;
    cg::this_grid().sync();
    xbar = xcd_barrier_post((unsigned*)ws + CTL_BAR, bst);
    if constexpr (IN(0)) {
        LAS float* scr = (LAS float*)(lds + wid * 16384);
        constexpr int I_IN = (DM / 64) * (2 * FF / 32), I_OUT = (FF / 64) * (DM / 32), I_MI = (DM / 64) * (4096 / 32), I_MO = (DM / 64) * (DM / 32);
        constexpr int NIT = 2 * I_IN + 2 * I_OUT + I_MI + I_MO;
        for (int it = gw; it < NIT; it += ngw) {
            int q = it;
            if (q < I_IN) { transpose_item<1>(p.in[4], DM, 2 * FF, W1in, scr, q, lane, p.in[3]); continue; } q -= I_IN;
            if (q < I_IN) { transpose_item<1>(p.in[18], DM, 2 * FF, W2in, scr, q, lane, p.in[17]); continue; } q -= I_IN;
            if (q < I_OUT) { transpose_item<0>(p.in[5], FF, DM, W1out, scr, q, lane, nullptr); continue; } q -= I_OUT;
            if (q < I_OUT) { transpose_item<0>(p.in[19], FF, DM, W2out, scr, q, lane, nullptr); continue; } q -= I_OUT;
            if (q < I_MI) { transpose_item<0>(p.in[8], DM, 4096, Wmin, scr, q, lane, p.in[7]); continue; } q -= I_MI;
            transpose_item<0>(p.in[15], DM, DM, Wmout, scr, q, lane, nullptr);
        }
        if (bx == 0) for (int e = tid; e < 1024; e += 512) { const int d = e >> 9, cc = e & 511; const float l0 = p.in[2][d * 1024 + cc], l1 = p.in[2][d * 1024 + 512 + cc];
            ((float*)(ws + WS_LB))[e] = 1.0f / (1.0f + __expf(l1 - l0)); }
        norm_rows<false, false, true>(gw, ngw, lane, x, nullptr, nullptr, nullptr, 0.f, part, nullptr, XN);
    }
    GSYNC(0);
    if constexpr (IN(1)) {
        LAS float* rsl = (LAS float*)(lds + 131072 + 8192); fill_row_scales(rsl, part, bx, tid);
        pg8::Gemm g{XN, W1in, M, 2 * FF, DM}; pg8::StaticOrder S; S.init(M, 2 * FF, G, bx); EpiSwiglu E{BIG, rsl};
        pg8::gemm_phase<EpiSwiglu, pg8::StaticOrder, true, true>(lds, g, S, E);
    }
    GSYNC(1);
    if constexpr (IN(2)) {
        pg8::Gemm g{BIG, W1out, M, DM, FF}; pg8::StaticOrder S; S.init(M, DM, G, bx);
        LAS float* wl = (LAS float*)(lds + 131072 + 8192); stage_gain(wl, p.in[6], tid);
        EpiResNorm<false, true> E{XN, nullptr, wl, 0.5f, XN, part, xb, ctl, xl};
        pg8::gemm_phase<EpiResNorm<false, true>, pg8::StaticOrder, true, true>(lds, g, S, E);
    }
    GSYNC(2);
    if constexpr (IN(3)) {
        LAS float* rsl = (LAS float*)(lds + 131072 + 8192); fill_row_scales(rsl, part, bx, tid);
        LAS float* lbs = (LAS float*)(lds + 131072 + 12288); stage_gain(lbs, (const float*)(ws + WS_LB), tid);
        pg8::Gemm g{XN, Wmin, M, 4096, DM}; pg8::StaticOrder S; S.init(M, 4096, G, bx); EpiMix E{BIG, lbs, rsl};
        pg8::gemm_phase<EpiMix, pg8::StaticOrder, true, true>(lds, g, S, E);
    }
    GSYNC(3);
    if constexpr (IN(4)) {
        for (int item = vcu; item < 256; item += G) hgrn_phase(lds, BIG, Y, item);
    }
    GSYNC(4);
    bf16_t* CAT = BIG + (size_t)MB_QR * MIXSZ;
    if constexpr (IN(5)) {
        attn_phase(lds, BIG + (size_t)MB_QA * MIXSZ, BIG + (size_t)MB_KA * MIXSZ, BIG + (size_t)MB_VA * MIXSZ, CAT, Y, Y + MIXSZ, BIG + (size_t)MB_GR * MIXSZ, p.in[14],
                   p.in[1], p.in[9], p.in[10], p.in[11], p.in[12], p.in[13], vcu);
    }
    GSYNC(5);
    bf16_t* XN2 = (bf16_t*)(ws + WS_XN2);
    if constexpr (IN(6)) {
        pg8::Gemm g{CAT, Wmout, M, DM, DM}; pg8::StaticOrder S; S.init(M, DM, G, bx);
        LAS float* wl = (LAS float*)(lds + 131072 + 8192); stage_gain(wl, p.in[16], tid);
        EpiResNorm<false, true> E{XN, nullptr, wl, 1.0f, XN2, part, xb + 262144, ctl + 256 * 64, xl};
        pg8::gemm_phase<EpiResNorm<false, true>, pg8::StaticOrder, true, true>(lds, g, S, E);
    }
    GSYNC(6);
    if constexpr (IN(7)) {
        LAS float* rsl = (LAS float*)(lds + 131072 + 8192); fill_row_scales(rsl, part, bx, tid);
        pg8::Gemm g{XN2, W2in, M, 2 * FF, DM}; pg8::StaticOrder S; S.init(M, 2 * FF, G, bx); EpiSwiglu E{BIG, rsl};
        pg8::gemm_phase<EpiSwiglu, pg8::StaticOrder, true, true>(lds, g, S, E);
    }
    GSYNC(7);
    if constexpr (IN(8)) {
        pg8::Gemm g{BIG, W2out, M, DM, FF}; pg8::StaticOrder S; S.init(M, DM, G, bx);
        LAS float* wl = (LAS float*)(lds + 131072 + 8192); stage_gain(wl, p.in[20], tid);
        EpiResNorm<true, true> E{XN2, out, wl, 0.5f, nullptr, nullptr, xb + 2 * 262144, ctl + 2 * 256 * 64, xl};
        pg8::gemm_phase<EpiResNorm<true, true>, pg8::StaticOrder, true, true>(lds, g, S, E);
    }
#undef IN
#undef GSYNC
}

extern "C" void kernel_launch(void* const* d_in, const int* in_sizes, int n_in, void* d_out, int out_size, void* d_ws, size_t ws_size, hipStream_t stream) {
    static int grid = 0;
    if (grid == 0) {
        if (n_in != 21 || out_size != M * DM || ws_size < 960 * MiB) { fprintf(stderr, "kernel_launch: unexpected shapes (n_in %d out %d ws %zu)\n", n_in, out_size, ws_size); grid = -1; return; }
        int dev = 0, cus = 0, per_cu = 0;
        (void)hipGetDevice(&dev); (void)hipDeviceGetAttribute(&cus, hipDeviceAttributeMultiprocessorCount, dev);
        if (hipFuncSetAttribute((const void*)mega<0, 9>, hipFuncAttributeMaxDynamicSharedMemorySize, LDS_BYTES) != hipSuccess) { fprintf(stderr, "kernel_launch: hipFuncSetAttribute failed\n"); grid = -1; return; }
        if (hipOccupancyMaxActiveBlocksPerMultiprocessor(&per_cu, (const void*)mega<0, 9>, 512, LDS_BYTES) != hipSuccess || per_cu < 1) fprintf(stderr, "kernel_launch: occupancy query says %d\n", per_cu);
        (void)hipGetLastError();
        grid = cus > 0 ? cus : 256;
        if (grid != 256) fprintf(stderr, "kernel_launch: %d CUs: the fused row-statistics exchange assumes 256 workgroups\n", grid);
    }
    if (grid < 0) return;
    Params p{};
    for (int i = 0; i < 21; ++i) p.in[i] = (const float*)d_in[i];
    p.out = (float*)d_out; p.ws = (unsigned char*)d_ws;
    void* args[] = {&p};
    hipError_t e = hipLaunchCooperativeKernel((const void*)mega<0, 9>, dim3(grid), dim3(512), args, LDS_BYTES, stream);
    if (e != hipSuccess) fprintf(stderr, "kernel_launch: cooperative launch failed: %s (grid %d)\n", hipGetErrorString(e), grid);
}
```
